# Optimizing an MI355X kernel written in HIP

```python
import math
import jax, jax.numpy as jnp
from jax import lax
import numpy as np

D_MODEL = 1024
BATCH = 2
SEQ = 8192
DEPTH = 1
DEC_BATCH = 8
DEC_SEQ = 4096
PAST_LEN = 128

HEAD_DIM = 64
SSD_HEADS = 8
SSD_WIDTH = SSD_HEADS * HEAD_DIM
SSD_GROUPS = 2
SSD_STATE = 128
SSD_CONV = 5
SSD_CHUNK = 128
ATT_HEADS = 8
ATT_WIDTH = ATT_HEADS * HEAD_DIM
MIX_WIDTH = SSD_WIDTH + ATT_WIDTH
DILATED_PATTERNS = ((128, 1), (512, 4), (2048, 16))
ROPE_DIMS = HEAD_DIM // 4
ROPE_THETA = 500000.0
MEM_LEN = 256
XATT_HEADS = 4
XATT_HEAD_DIM = D_MODEL // XATT_HEADS
D_FF = 4 * D_MODEL
EPS = 1e-6
NEG_INF = -1e30
CONV_CH = SSD_WIDTH + 2 * SSD_GROUPS * SSD_STATE
OFF_Z = 0
OFF_XBC = OFF_Z + SSD_WIDTH
OFF_DT = OFF_XBC + CONV_CH
OFF_Q = OFF_DT + 2 * SSD_HEADS
OFF_K = OFF_Q + ATT_WIDTH
OFF_V = OFF_K + ATT_WIDTH
IN_COLS = OFF_V + ATT_WIDTH

kernel_name = 'hymba_ssd_dilated_encoder'


def rmsnorm(x, g):
    xf = x.astype(jnp.float32)
    y = xf * lax.rsqrt(jnp.mean(xf * xf, axis=-1, keepdims=True) + EPS)
    return (y * g.astype(jnp.float32)).astype(x.dtype)


def rope_partial(t, pos):
    half = ROPE_DIMS // 2
    inv_freq = jnp.power(jnp.float32(ROPE_THETA), -jnp.arange(half, dtype=jnp.float32) / half)
    ang = pos.astype(jnp.float32)[:, None] * inv_freq[None, :]
    cos = jnp.cos(ang)[:, None, :]
    sin = jnp.sin(ang)[:, None, :]
    t1 = t[..., :half]
    t2 = t[..., half:ROPE_DIMS]
    return jnp.concatenate([t1 * cos - t2 * sin, t2 * cos + t1 * sin, t[..., ROPE_DIMS:]], axis=-1)


def centred_depthwise_conv(u, w, b):
    pad = (SSD_CONV - 1) // 2
    out = lax.conv_general_dilated(u, w[:, None, :].astype(u.dtype), window_strides=(1,),
                                   padding=[(pad, pad)], dimension_numbers=('NWC', 'WIO', 'NWC'),
                                   feature_group_count=u.shape[-1])
    return out + b.astype(u.dtype)


def ssd_chunked_scan(x, dt, A, Bm, Cm):
    bsz, l, h, p = x.shape
    g, n = Bm.shape[2], Bm.shape[3]
    r = h // g
    q = SSD_CHUNK
    c = l // q
    x = x.reshape(bsz, c, q, g, r, p)
    dt = dt.reshape(bsz, c, q, g, r)
    Bm = Bm.reshape(bsz, c, q, g, n)
    Cm = Cm.reshape(bsz, c, q, g, n)
    a_cs = jnp.cumsum(dt * A.reshape(g, r), axis=2)
    xdt = x * dt[..., None]
    causal = jnp.tril(jnp.ones((q, q), dtype=bool))[:, :, None, None]
    seg = a_cs[:, :, :, None] - a_cs[:, :, None, :]
    lmat = jnp.where(causal, jnp.exp(jnp.where(causal, seg, 0.0)), 0.0)
    cb = jnp.einsum('bcign,bcjgn->bcijg', Cm, Bm)
    y_diag = jnp.einsum('bcijg,bcijgr,bcjgrp->bcigrp', cb, lmat, xdt)
    decay_to_end = jnp.exp(a_cs[:, :, -1:] - a_cs)
    chunk_states = jnp.einsum('bcjgn,bcjgr,bcjgrp->bcgrpn', Bm, decay_to_end, xdt)
    chunk_decay = jnp.exp(a_cs[:, :, -1])

    def step(carry, inp):
        st, dec = inp
        return carry * dec[..., None, None] + st, carry

    init = jnp.zeros((bsz, g, r, p, n), jnp.float32)
    _, prev = lax.scan(step, init, (jnp.moveaxis(chunk_states, 1, 0), jnp.moveaxis(chunk_decay, 1, 0)))
    prev = jnp.moveaxis(prev, 0, 1)
    y_off = jnp.einsum('bcign,bcgrpn,bcigr->bcigrp', Cm, prev, jnp.exp(a_cs))
    return (y_diag + y_off).reshape(bsz, l, h, p)


def ssd_mixer(u_z, u_xbc, u_dt, conv_w, conv_b, A_log, dt_bias, D, norm_g):
    bsz, s, _ = u_z.shape
    xbc = jax.nn.silu(centred_depthwise_conv(u_xbc, conv_w, conv_b)).astype(jnp.float32)
    xs = xbc[..., :SSD_WIDTH].reshape(bsz, s, SSD_HEADS, HEAD_DIM)
    nbc = SSD_GROUPS * SSD_STATE
    Bm = xbc[..., SSD_WIDTH:SSD_WIDTH + nbc].reshape(bsz, s, SSD_GROUPS, SSD_STATE)
    Cm = xbc[..., SSD_WIDTH + nbc:].reshape(bsz, s, SSD_GROUPS, SSD_STATE)
    dt = jax.nn.softplus(u_dt.astype(jnp.float32).reshape(bsz, s, 2, SSD_HEADS) + dt_bias.astype(jnp.float32))
    A = -jnp.exp(A_log.astype(jnp.float32))
    flip = lambda t: jnp.flip(t, axis=1)
    y_fwd = ssd_chunked_scan(xs, dt[:, :, 0], A[0], Bm, Cm)
    y_bwd = flip(ssd_chunked_scan(flip(xs), flip(dt[:, :, 1]), A[1], flip(Bm), flip(Cm)))
    y = (y_fwd + y_bwd + D.astype(jnp.float32)[:, None] * xs).reshape(bsz, s, SSD_WIDTH)
    y = y * jax.nn.silu(u_z.astype(jnp.float32))
    return rmsnorm(y, norm_g)


def band_pattern(q, k, v, dil, half):
    bsz, s, h, e = q.shape
    L = s // dil
    blk = half
    nb = -(-L // blk)
    Lp = nb * blk

    def to_classes(t, lo, hi):
        t = t.reshape(bsz, L, dil, h, e).transpose(0, 2, 1, 3, 4)
        return jnp.pad(t, ((0, 0), (0, 0), (lo, hi), (0, 0), (0, 0)))

    def windows(t):
        tr = to_classes(t, blk, Lp - L + blk).reshape(bsz, dil, nb + 2, blk, h, e)
        return jnp.concatenate([tr[:, :, :-2], tr[:, :, 1:-1], tr[:, :, 2:]], axis=3)

    qc = to_classes(q, 0, Lp - L).reshape(bsz, dil, nb, blk, h, e)
    kw = windows(k)
    vw = windows(v)
    ii = jnp.arange(blk)[:, None]
    tt = jnp.arange(3 * blk)[None, :]
    delta = tt - blk - ii
    m_k = jnp.arange(nb)[:, None, None] * blk - blk + tt[None]
    valid = (jnp.abs(delta) <= half)[None] & (m_k >= 0) & (m_k < L)
    scores = jnp.einsum('bdnihe,bdnthe->bdnhit', qc, kw) / math.sqrt(e)
    scores = jnp.where(valid[:, None], scores, NEG_INF)
    mx = jnp.max(scores, axis=-1, keepdims=True)
    pr = jnp.exp(scores - mx)
    den = jnp.sum(pr, axis=-1)
    o = jnp.einsum('bdnhit,bdnthe->bdnihe', pr, vw) / jnp.moveaxis(den, 3, 4)[..., None]
    lse = jnp.moveaxis(mx[..., 0] + jnp.log(den), 3, 4)

    def from_classes(t):
        tail = t.shape[4:]
        t = t.reshape(bsz, dil, Lp, *tail)[:, :, :L]
        return jnp.swapaxes(t, 1, 2).reshape(bsz, s, *tail)

    return from_classes(o), from_classes(lse)


def dilated_attention(q, k, v):
    outs = []
    lses = []
    for window, dil in DILATED_PATTERNS:
        o, lse = band_pattern(q, k, v, dil, window // (2 * dil))
        outs.append(o)
        lses.append(lse)
    w = jax.nn.softmax(jnp.stack(lses, axis=0), axis=0)
    return jnp.sum(w[..., None] * jnp.stack(outs, axis=0), axis=0)


def attention_mixer(u_q, u_k, u_v, q_g, k_g, out_g):
    bsz, s, _ = u_q.shape
    pos = jnp.arange(s)
    shp = (bsz, s, ATT_HEADS, HEAD_DIM)
    q = rope_partial(rmsnorm(u_q.reshape(shp).astype(jnp.float32), q_g), pos)
    k = rope_partial(rmsnorm(u_k.reshape(shp).astype(jnp.float32), k_g), pos)
    v = u_v.reshape(shp).astype(jnp.float32)
    o = dilated_attention(q, k, v).reshape(bsz, s, ATT_WIDTH)
    return rmsnorm(o, out_g)


def memory_cross_attention(hn, memn, wq, wkv, q_g, k_g, wo):
    bsz, s, _ = hn.shape
    m = memn.shape[1]
    q = (hn @ wq).reshape(bsz, s, XATT_HEADS, XATT_HEAD_DIM).astype(jnp.float32)
    kv = (memn @ wkv).reshape(bsz, m, 2, XATT_HEADS, XATT_HEAD_DIM).astype(jnp.float32)
    q = rmsnorm(q, q_g)
    k = rmsnorm(kv[:, :, 0], k_g)
    v = kv[:, :, 1]
    sc = jnp.einsum('bshe,bmhe->bhsm', q, k) / math.sqrt(XATT_HEAD_DIM)
    p = jax.nn.softmax(sc, axis=-1)
    o = jnp.einsum('bhsm,bmhe->bshe', p, v).reshape(bsz, s, D_MODEL)
    return o.astype(hn.dtype) @ wo


def encoder_layer(x, mem, p):
    u = rmsnorm(x, p['mix_norm_g']) @ p['w_in']
    ssd_out = ssd_mixer(u[..., OFF_Z:OFF_XBC], u[..., OFF_XBC:OFF_DT], u[..., OFF_DT:OFF_Q],
                        p['conv_w'], p['conv_b'], p['ssd_A_log'], p['ssd_dt_bias'], p['ssd_D'],
                        p['ssd_norm_g'])
    att_out = attention_mixer(u[..., OFF_Q:OFF_K], u[..., OFF_K:OFF_V], u[..., OFF_V:IN_COLS],
                              p['att_q_norm_g'], p['att_k_norm_g'], p['att_out_norm_g'])
    h = x + jnp.concatenate([ssd_out, att_out], axis=-1).astype(x.dtype) @ p['w_out']
    h = h + memory_cross_attention(rmsnorm(h, p['xatt_norm_g']), rmsnorm(mem, p['mem_norm_g']),
                                   p['xatt_wq'], p['xatt_wkv'], p['xatt_q_norm_g'],
                                   p['xatt_k_norm_g'], p['xatt_wo'])
    hm = rmsnorm(h, p['mlp_norm_g'])
    return h + jnp.square(jax.nn.relu(hm @ p['mlp_w1'])) @ p['mlp_w2']


def trunk(x, mem, params):
    for layer in range(DEPTH):
        x = encoder_layer(x, mem, {name: arr[layer] for name, arr in params.items()})
    return x


def setup_inputs(seed: int = 0) -> dict:
    key = jax.random.key(seed)
    ks = jax.random.split(key, 32)
    f32 = jnp.float32
    nrm = lambda k, shape, scale: jax.random.normal(k, shape, f32) * scale
    gain = lambda k, n: 1.0 + 0.02 * jax.random.normal(k, (DEPTH, n), f32)
    dt0 = jnp.exp(jax.random.uniform(ks[8], (DEPTH, 2, SSD_HEADS), f32, math.log(1e-3), math.log(1e-1)))
    return {
        'x_prompt': nrm(ks[0], (BATCH, SEQ, D_MODEL), 1.0),
        'x_sample': nrm(ks[1], (DEC_BATCH, DEC_SEQ, D_MODEL), 1.0),
        'mem_prompt': nrm(ks[2], (BATCH, MEM_LEN, D_MODEL), 1.0),
        'mem_sample': nrm(ks[3], (DEC_BATCH, MEM_LEN, D_MODEL), 1.0),
        'mix_norm_g': gain(ks[4], D_MODEL),
        'w_in': nrm(ks[5], (DEPTH, D_MODEL, IN_COLS), D_MODEL ** -0.5),
        'conv_w': nrm(ks[6], (DEPTH, SSD_CONV, CONV_CH), SSD_CONV ** -0.5),
        'conv_b': nrm(ks[7], (DEPTH, CONV_CH), 0.02),
        'ssd_A_log': jnp.log(jax.random.uniform(ks[9], (DEPTH, 2, SSD_HEADS), f32, 1.0, 16.0)),
        'ssd_dt_bias': dt0 + jnp.log(-jnp.expm1(-dt0)),
        'ssd_D': 1.0 + 0.02 * jax.random.normal(ks[10], (DEPTH, SSD_HEADS), f32),
        'ssd_norm_g': gain(ks[11], SSD_WIDTH),
        'att_q_norm_g': gain(ks[12], HEAD_DIM),
        'att_k_norm_g': gain(ks[13], HEAD_DIM),
        'att_out_norm_g': gain(ks[14], ATT_WIDTH),
        'w_out': nrm(ks[15], (DEPTH, MIX_WIDTH, D_MODEL), MIX_WIDTH ** -0.5),
        'xatt_norm_g': gain(ks[16], D_MODEL),
        'mem_norm_g': gain(ks[17], D_MODEL),
        'xatt_wq': nrm(ks[18], (DEPTH, D_MODEL, D_MODEL), D_MODEL ** -0.5),
        'xatt_wkv': nrm(ks[19], (DEPTH, D_MODEL, 2 * D_MODEL), D_MODEL ** -0.5),
        'xatt_q_norm_g': gain(ks[20], XATT_HEAD_DIM),
        'xatt_k_norm_g': gain(ks[21], XATT_HEAD_DIM),
        'xatt_wo': nrm(ks[22], (DEPTH, D_MODEL, D_MODEL), D_MODEL ** -0.5),
        'mlp_norm_g': gain(ks[23], D_MODEL),
        'mlp_w1': nrm(ks[24], (DEPTH, D_MODEL, D_FF), D_MODEL ** -0.5),
        'mlp_w2': nrm(ks[25], (DEPTH, D_FF, D_MODEL), D_FF ** -0.5),
    }


def reference(x_prompt, x_sample, mem_prompt, mem_sample, mix_norm_g, w_in, conv_w, conv_b,
              ssd_A_log, ssd_dt_bias, ssd_D, ssd_norm_g, att_q_norm_g, att_k_norm_g, att_out_norm_g,
              w_out, xatt_norm_g, mem_norm_g, xatt_wq, xatt_wkv, xatt_q_norm_g, xatt_k_norm_g,
              xatt_wo, mlp_norm_g, mlp_w1, mlp_w2):
    params = {
        'mix_norm_g': mix_norm_g, 'w_in': w_in, 'conv_w': conv_w, 'conv_b': conv_b,
        'ssd_A_log': ssd_A_log, 'ssd_dt_bias': ssd_dt_bias, 'ssd_D': ssd_D, 'ssd_norm_g': ssd_norm_g,
        'att_q_norm_g': att_q_norm_g, 'att_k_norm_g': att_k_norm_g, 'att_out_norm_g': att_out_norm_g,
        'w_out': w_out, 'xatt_norm_g': xatt_norm_g, 'mem_norm_g': mem_norm_g, 'xatt_wq': xatt_wq,
        'xatt_wkv': xatt_wkv, 'xatt_q_norm_g': xatt_q_norm_g, 'xatt_k_norm_g': xatt_k_norm_g,
        'xatt_wo': xatt_wo, 'mlp_norm_g': mlp_norm_g, 'mlp_w1': mlp_w1, 'mlp_w2': mlp_w2,
    }
    y_prompt = trunk(x_prompt, mem_prompt, params)
    y_sample = trunk(x_sample, mem_sample, params)
    return (y_prompt, y_sample)
```

```cpp
#include <hip/hip_runtime.h>
#include <hip/hip_cooperative_groups.h>
#include <cstdio>
#include <cstdint>
namespace cg = cooperative_groups;
namespace pg8 {
#define PG8_LAS __attribute__((address_space(3)))
typedef unsigned short bf16_t;
typedef short bf16x8 __attribute__((ext_vector_type(8)));
typedef float f32x4 __attribute__((ext_vector_type(4)));
typedef unsigned u32x4 __attribute__((ext_vector_type(4)));
constexpr int BM = 256, BK = 64, HALF = 128, HTB = HALF * BK * 2  , STAGE_BYTES = 8 * HTB, NXCD = 8, WGM = 8;

__host__ __device__ __forceinline__ int lds_byte(int r, int c) { const int st = (r >> 4) * 2 + (c >> 5), rr = r & 15, cc = c & 31, ob = rr * 64 + cc * 2; return st * 1024 + (ob ^ (((ob >> 9) & 1) << 5)); }
__host__ __device__ __forceinline__ void stage_rc(int b, int& R, int& C) { const int st = b / 1024, sb = b % 1024, swz = sb ^ (((sb >> 9) & 1) << 5); R = (st >> 1) * 16 + swz / 64; C = (st & 1) * 32 + (swz % 64) / 2; }
__host__ __device__ __forceinline__ int perm32(int rho) { const int n = rho >> 4, i = rho & 15; return 8 * (i >> 2) + 4 * n + (i & 3); }

struct Unit { int pm, pn; };
struct Gemm { const bf16_t* A; const bf16_t* Bt; int M, N, K; };

struct StaticOrder {
    int nM, nN, nwg, G, c;
    __host__ __device__ void init(int M, int N, int G_, int c_) { nM = M / BM; nN = N / BM; nwg = nM * nN; G = G_; c = c_; }
    __host__ __device__ bool next(int i, Unit& u) const {
        const long L = (long)i * G + c; if (L >= nwg) return false;
        int wgid = (int)L; { const int q = nwg / NXCD, r = nwg % NXCD, xcd = wgid % NXCD, off = wgid / NXCD; wgid = (xcd < r ? xcd * (q + 1) : r * (q + 1) + (xcd - r) * q) + off; }
        const int nig = WGM * nN, gid = wgid / nig, fm = gid * WGM, gsz = (nM - fm) < WGM ? (nM - fm) : WGM;
        u.pm = fm + ((wgid % nig) % gsz); u.pn = (wgid % nig) / gsz; return true;
    }
    __device__ __forceinline__ void a_ready(const Unit&) const {}
    __device__ __forceinline__ void done(const Unit&) const {}
};

__device__ __forceinline__ unsigned cvt_pk_bf16(float lo, float hi) { unsigned r; asm volatile("v_cvt_pk_bf16_f32 %0, %1, %2" : "=v"(r) : "v"(lo), "v"(hi)); return r; }
typedef float f32x2 __attribute__((ext_vector_type(2)));
template <class Epi, class Sched, bool ALIGN_EPI = false, bool SP2 = false>
__device__ __forceinline__ void gemm_phase(PG8_LAS unsigned char* lds, const Gemm g, const Sched& S, const Epi& E) {
    const int tid = threadIdx.x, wid = __builtin_amdgcn_readfirstlane(tid >> 6), lane = tid & 63, wr = wid >> 2, wc = wid & 3, fr = lane & 15, fq = lane >> 4;
    const int K = g.K, nt = K / BK;
    unsigned voffA[2], voffB[2];
#pragma unroll
    for (int i = 0; i < 2; ++i) { int R, C; stage_rc(tid * 16 + i * 8192, R, C); const int Rb = Epi::PERM ? ((R & ~31) + perm32(R & 31)) : R;
        voffA[i] = (unsigned)(R * K + C) * 2u; voffB[i] = (unsigned)(Rb * K + C) * 2u; }
    const size_t kstep = (size_t)(BK * 2);
    const size_t hstep = (size_t)HALF * K * 2;
    const size_t tstep = 2 * hstep;
    const unsigned ldsw = (unsigned)wid * 1024u;
    const int aoff = lds_byte(wr * 64 + fr, fq * 8), boff = lds_byte(wc * 32 + fr, fq * 8);
#define PG8_SA(b, h) (((b) * 2 + (h)) * HTB)
#define PG8_SB(b, h) ((4 + (b) * 2 + (h)) * HTB)
#define PG8_STAGE(bufoff, gbase, voff) do { _Pragma("unroll") for (int _i = 0; _i < 2; ++_i) \
        __builtin_amdgcn_global_load_lds((const unsigned*)((const char*)(gbase) + (voff)[_i]), (PG8_LAS unsigned*)(lds + (bufoff) + ldsw + _i * 8192), 16, 0, 0); } while (0)
#define PG8_LDA(dst, b, h) do { _Pragma("unroll") for (int m = 0; m < 4; ++m) _Pragma("unroll") for (int k = 0; k < 2; ++k) dst[m][k] = *(const PG8_LAS bf16x8*)(lds + PG8_SA(b, h) + aoff + m * 2048 + k * 1024); } while (0)
#define PG8_LDB(dst, b, h) do { _Pragma("unroll") for (int n = 0; n < 2; ++n) _Pragma("unroll") for (int k = 0; k < 2; ++k) dst[n][k] = *(const PG8_LAS bf16x8*)(lds + PG8_SB(b, h) + boff + n * 2048 + k * 1024); } while (0)
#define PG8_MMA(ai, bj, At, Bt) do { __builtin_amdgcn_s_setprio(1); _Pragma("unroll") for (int m = 0; m < 4; ++m) _Pragma("unroll") for (int n = 0; n < 2; ++n) _Pragma("unroll") for (int k = 0; k < 2; ++k) \
        acc[ai][bj][m][n] = __builtin_amdgcn_mfma_f32_16x16x32_bf16(Bt[n][k], At[m][k], acc[ai][bj][m][n], 0, 0, 0); __builtin_amdgcn_s_setprio(0); } while (0)
#define PG8_WAIT_V(n) asm volatile("s_waitcnt vmcnt(" #n ")" ::: "memory")
#define PG8_WAIT_L(n) asm volatile("s_waitcnt lgkmcnt(" #n ")" ::: "memory")
#define PG8_BAR __builtin_amdgcn_s_barrier()
#define PG8_SCHED __builtin_amdgcn_sched_barrier(0)
    Unit cur, nxt; int ui = 0;
    if (!S.next(0, cur)) return;
    f32x4 acc[2][2][4][2];
#pragma unroll
    for (int a = 0; a < 2; ++a)
#pragma unroll
        for (int b = 0; b < 2; ++b)
#pragma unroll
            for (int m = 0; m < 4; ++m)
#pragma unroll
                for (int n = 0; n < 2; ++n) acc[a][b][m][n] = (f32x4){0.f, 0.f, 0.f, 0.f};
    bf16x8 At[4][2], B0[2][2], B1[2][2];
    const char* cA = (const char*)g.A + (size_t)cur.pm * tstep; const char* cB = (const char*)g.Bt + (size_t)cur.pn * tstep;
    S.a_ready(cur);
    if constexpr (SP2) {
        PG8_STAGE(PG8_SB(0, 0), cB, voffB); PG8_STAGE(PG8_SB(0, 1), cB + hstep, voffB); PG8_STAGE(PG8_SA(0, 0), cA, voffA); PG8_STAGE(PG8_SA(0, 1), cA + hstep, voffA);
        if (wr == 1) PG8_BAR;
        PG8_WAIT_V(2); PG8_BAR;
        PG8_STAGE(PG8_SB(1, 0), cB + kstep, voffB); PG8_STAGE(PG8_SA(1, 0), cA + kstep, voffA); PG8_STAGE(PG8_SB(1, 1), cB + hstep + kstep, voffB);
        PG8_WAIT_V(6); PG8_BAR;
    } else {
        PG8_STAGE(PG8_SB(0, 0), cB, voffB); PG8_STAGE(PG8_SA(0, 0), cA, voffA); PG8_STAGE(PG8_SB(0, 1), cB + hstep, voffB); PG8_STAGE(PG8_SA(0, 1), cA + hstep, voffA);
        if (wr == 1) PG8_BAR;
        PG8_WAIT_V(4); PG8_BAR;
        PG8_STAGE(PG8_SB(1, 0), cB + kstep, voffB); PG8_STAGE(PG8_SA(1, 0), cA + kstep, voffA); PG8_STAGE(PG8_SB(1, 1), cB + hstep + kstep, voffB);
        PG8_WAIT_V(6); PG8_BAR;
    }
    for (;;) {
        const bool has_next = S.next(ui + 1, nxt);
        const char* nA = has_next ? (const char*)g.A + (size_t)nxt.pm * tstep : cA; const char* nB = has_next ? (const char*)g.Bt + (size_t)nxt.pn * tstep : cB;
        for (int t = 0; t < nt; t += 2) {
            const bool last = (t == nt - 2);
            const char* a1 = cA + (size_t)(t + 1) * kstep;
            const char* a2 = last ? nA : cA + (size_t)(t + 2) * kstep; const char* b2 = last ? nB : cB + (size_t)(t + 2) * kstep;
            const char* a3 = a2 + kstep; const char* b3 = b2 + kstep;
            if (last && has_next) S.a_ready(nxt);
            if constexpr (SP2) {
            PG8_LDB(B0, 0, 0); PG8_LDB(B1, 0, 1); PG8_SCHED; PG8_LDA(At, 0, 0); PG8_STAGE(PG8_SA(1, 1), a1 + hstep, voffA);
            PG8_WAIT_V(8); PG8_WAIT_L(0); PG8_BAR; PG8_MMA(0, 0, At, B0); PG8_MMA(0, 1, At, B1); PG8_BAR; PG8_SCHED;
            PG8_LDA(At, 0, 1); PG8_STAGE(PG8_SB(0, 0), b2, voffB); PG8_STAGE(PG8_SB(0, 1), b2 + hstep, voffB); PG8_STAGE(PG8_SA(0, 0), a2, voffA);
            PG8_WAIT_V(8); PG8_WAIT_L(0); PG8_BAR; PG8_MMA(1, 0, At, B0); PG8_MMA(1, 1, At, B1); PG8_BAR; PG8_SCHED;
            PG8_LDB(B0, 1, 0); PG8_LDB(B1, 1, 1); PG8_SCHED; PG8_LDA(At, 1, 0); PG8_STAGE(PG8_SA(0, 1), a2 + hstep, voffA);
            PG8_WAIT_V(8); PG8_WAIT_L(0); PG8_BAR; PG8_MMA(0, 0, At, B0); PG8_MMA(0, 1, At, B1); PG8_BAR; PG8_SCHED;
            PG8_LDA(At, 1, 1); PG8_STAGE(PG8_SB(1, 0), b3, voffB); PG8_STAGE(PG8_SB(1, 1), b3 + hstep, voffB); PG8_STAGE(PG8_SA(1, 0), a3, voffA);
            PG8_WAIT_V(8); PG8_WAIT_L(0); PG8_BAR; PG8_MMA(1, 0, At, B0); PG8_MMA(1, 1, At, B1); PG8_BAR; PG8_SCHED;
            } else {
            PG8_LDB(B0, 0, 0); PG8_SCHED; PG8_LDA(At, 0, 0); PG8_STAGE(PG8_SA(1, 1), a1 + hstep, voffA);
            PG8_WAIT_L(8); PG8_BAR; PG8_WAIT_L(0); PG8_MMA(0, 0, At, B0); PG8_BAR; PG8_SCHED;
            PG8_LDB(B1, 0, 1); PG8_STAGE(PG8_SB(0, 0), b2, voffB);
            PG8_BAR; PG8_WAIT_L(0); PG8_MMA(0, 1, At, B1); PG8_BAR;
            PG8_LDA(At, 0, 1); PG8_STAGE(PG8_SA(0, 0), a2, voffA);
            PG8_BAR; PG8_WAIT_L(0); PG8_MMA(1, 0, At, B0); PG8_BAR; PG8_SCHED;
            PG8_STAGE(PG8_SB(0, 1), b2 + hstep, voffB);
            PG8_WAIT_V(6); PG8_BAR; PG8_MMA(1, 1, At, B1); PG8_BAR;
            PG8_LDB(B0, 1, 0); PG8_SCHED; PG8_LDA(At, 1, 0); PG8_STAGE(PG8_SA(0, 1), a2 + hstep, voffA);
            PG8_WAIT_L(8); PG8_BAR; PG8_WAIT_L(0); PG8_MMA(0, 0, At, B0); PG8_BAR; PG8_SCHED;
            PG8_LDB(B1, 1, 1); PG8_STAGE(PG8_SB(1, 0), b3, voffB);
            PG8_BAR; PG8_WAIT_L(0); PG8_MMA(0, 1, At, B1); PG8_BAR;
            PG8_LDA(At, 1, 1); PG8_STAGE(PG8_SA(1, 0), a3, voffA);
            PG8_BAR; PG8_WAIT_L(0); PG8_MMA(1, 0, At, B0); PG8_BAR; PG8_SCHED;
            PG8_STAGE(PG8_SB(1, 1), b3 + hstep, voffB);
            PG8_WAIT_V(6); PG8_BAR; PG8_MMA(1, 1, At, B1); PG8_BAR;
            }
        }
        if constexpr (ALIGN_EPI) { if (wr == 0) PG8_BAR; }
        if constexpr (!Epi::AFTER_DRAIN) { E(acc, cur, wr, wc, fr, fq); S.done(cur); }
        if (!has_next) break;
#pragma unroll
        for (int a = 0; a < 2; ++a)
#pragma unroll
            for (int b = 0; b < 2; ++b)
#pragma unroll
                for (int m = 0; m < 4; ++m)
#pragma unroll
                    for (int n = 0; n < 2; ++n) acc[a][b][m][n] = (f32x4){0.f, 0.f, 0.f, 0.f};
        cur = nxt; cA = nA; cB = nB; ++ui;
        if constexpr (ALIGN_EPI) { if (wr == 1) PG8_BAR; }
    }
    PG8_WAIT_V(0);
    if constexpr (!ALIGN_EPI) { if (wr == 0) PG8_BAR; }
    PG8_BAR;
    if constexpr (Epi::AFTER_DRAIN) { E.fused(acc, cur, wr, wc, fr, fq, lds, wid, lane); S.done(cur); }
#undef PG8_SA
#undef PG8_SB
#undef PG8_STAGE
#undef PG8_LDA
#undef PG8_LDB
#undef PG8_MMA
#undef PG8_WAIT_V
#undef PG8_WAIT_L
#undef PG8_BAR
#undef PG8_SCHED
}
}
namespace pg8 {
constexpr int TPROMPT = 16384;
template <int MODE> struct EpiG {
    static constexpr bool PERM = true, AFTER_DRAIN = false;
    bf16_t* ob; int ldb; float* of; const float* r0; const float* r1; float* ssq; const float* rin; size_t split_stride; float* dt; const bf16_t* rb;
    __device__ __forceinline__ void operator()(const f32x4 (&acc)[2][2][4][2], const Unit& u, int wr, int wc, int fr, int fq) const {
        const int row0 = u.pm * BM + wr * 64 + fr; const int colt = u.pn * BM; const int cl = wc * 32 + 8 * fq;
        if (MODE == 2 || MODE == 5 || MODE == 7) {
            f32x4 ca[2][2]; u32x4 cb[2];
            { const int row = row0;
              if (MODE == 2) { const float* rp = (row < TPROMPT ? r0 + (size_t)row * 1024 : r1 + (size_t)(row - TPROMPT) * 1024) + colt + cl;
#pragma unroll
                  for (int bj = 0; bj < 2; ++bj) { ca[bj][0] = *(const f32x4*)(rp + bj * HALF); ca[bj][1] = *(const f32x4*)(rp + bj * HALF + 4); } }
              else { const bf16_t* rp = rb + (size_t)row * 1024 + colt + cl;
#pragma unroll
                  for (int bj = 0; bj < 2; ++bj) cb[bj] = *(const u32x4*)(rp + bj * HALF); } }
#pragma unroll
            for (int g = 0; g < 8; ++g) {
                const int ai = g >> 2, m = g & 3; const int row = row0 + ai * HALF + m * 16;
                f32x4 na[2][2]; u32x4 nb[2];
                if (g < 7) { const int nrow = row0 + ((g + 1) >> 2) * HALF + ((g + 1) & 3) * 16;
                    if (MODE == 2) { const float* rp = (nrow < TPROMPT ? r0 + (size_t)nrow * 1024 : r1 + (size_t)(nrow - TPROMPT) * 1024) + colt + cl;
#pragma unroll
                        for (int bj = 0; bj < 2; ++bj) { na[bj][0] = *(const f32x4*)(rp + bj * HALF); na[bj][1] = *(const f32x4*)(rp + bj * HALF + 4); } }
                    else { const bf16_t* rp = rb + (size_t)nrow * 1024 + colt + cl;
#pragma unroll
                        for (int bj = 0; bj < 2; ++bj) nb[bj] = *(const u32x4*)(rp + bj * HALF); } }
                float s = 0.f;
#pragma unroll
                for (int bj = 0; bj < 2; ++bj) {
                    f32x4 v0 = acc[ai][bj][m][0], v1 = acc[ai][bj][m][1];
                    if (MODE == 2) { v0 += ca[bj][0]; v1 += ca[bj][1]; }
                    else { const u32x4 rr = cb[bj];
                        v0[0] += __uint_as_float(rr.x << 16); v0[1] += __uint_as_float(rr.x & 0xffff0000u); v0[2] += __uint_as_float(rr.y << 16); v0[3] += __uint_as_float(rr.y & 0xffff0000u);
                        v1[0] += __uint_as_float(rr.z << 16); v1[1] += __uint_as_float(rr.z & 0xffff0000u); v1[2] += __uint_as_float(rr.w << 16); v1[3] += __uint_as_float(rr.w & 0xffff0000u); }
                    if (MODE == 7) { float* op = of + (size_t)row * 1024 + colt + cl + bj * HALF; *(f32x4*)op = v0; *(f32x4*)(op + 4) = v1; }
                    else { u32x4 w; w.x = cvt_pk_bf16(v0[0], v0[1]); w.y = cvt_pk_bf16(v0[2], v0[3]); w.z = cvt_pk_bf16(v1[0], v1[1]); w.w = cvt_pk_bf16(v1[2], v1[3]);
                        *(u32x4*)(ob + (size_t)row * 1024 + colt + cl + bj * HALF) = w;
                        s += (v0[0] * v0[0] + v0[1] * v0[1]) + (v0[2] * v0[2] + v0[3] * v0[3]) + (v1[0] * v1[0] + v1[1] * v1[1]) + (v1[2] * v1[2] + v1[3] * v1[3]); }
                }
                if (MODE != 7) { s += __shfl_xor(s, 16); s += __shfl_xor(s, 32); if (fq == 0) unsafeAtomicAdd(ssq + row, s); }
                if (g < 7) {
#pragma unroll
                    for (int bj = 0; bj < 2; ++bj) { if (MODE == 2) { ca[bj][0] = na[bj][0]; ca[bj][1] = na[bj][1]; } else cb[bj] = nb[bj]; } }
            }
            return;
        }
        float rsv[2][4];
        if (MODE == 3 || MODE == 6) {
#pragma unroll
            for (int ai = 0; ai < 2; ++ai)
#pragma unroll
                for (int m = 0; m < 4; ++m) rsv[ai][m] = rin[row0 + ai * HALF + m * 16];
#pragma unroll
            for (int ai = 0; ai < 2; ++ai)
#pragma unroll
                for (int m = 0; m < 4; ++m) rsv[ai][m] = 1.0f / sqrtf(rsv[ai][m] * (1.0f / 1024.0f) + 1e-6f);
        }
#pragma unroll
        for (int ai = 0; ai < 2; ++ai)
#pragma unroll
            for (int m = 0; m < 4; ++m) {
                const int row = row0 + ai * HALF + m * 16;
                if (MODE == 0) {
#pragma unroll
                    for (int bj = 0; bj < 2; ++bj) { const f32x4 v0 = acc[ai][bj][m][0], v1 = acc[ai][bj][m][1]; u32x4 w; w.x = cvt_pk_bf16(v0[0], v0[1]); w.y = cvt_pk_bf16(v0[2], v0[3]); w.z = cvt_pk_bf16(v1[0], v1[1]); w.w = cvt_pk_bf16(v1[2], v1[3]);
                        *(u32x4*)(ob + (size_t)row * ldb + colt + cl + bj * HALF) = w; }
                } else if (MODE == 1) {
                    if (u.pn < 12) { bf16_t* base = ob + (size_t)(u.pn >> 1) * split_stride + (size_t)row * 512 + (u.pn & 1) * 256 + cl;
#pragma unroll
                        for (int bj = 0; bj < 2; ++bj) { const f32x4 v0 = acc[ai][bj][m][0], v1 = acc[ai][bj][m][1]; u32x4 w; w.x = cvt_pk_bf16(v0[0], v0[1]); w.y = cvt_pk_bf16(v0[2], v0[3]); w.z = cvt_pk_bf16(v1[0], v1[1]); w.w = cvt_pk_bf16(v1[2], v1[3]);
                            *(u32x4*)(base + bj * HALF) = w; }
                    } else if (wc == 0 && fq < 2) { float* p = dt + (size_t)row * 16 + 8 * fq; *(f32x4*)p = acc[ai][0][m][0]; *(f32x4*)(p + 4) = acc[ai][0][m][1]; }
                } else if (MODE == 2) {
                    const float* rp = (row < TPROMPT ? r0 + (size_t)row * 1024 : r1 + (size_t)(row - TPROMPT) * 1024) + colt + cl; float s = 0.f;
#pragma unroll
                    for (int bj = 0; bj < 2; ++bj) { const f32x4 v0 = acc[ai][bj][m][0] + *(const f32x4*)(rp + bj * HALF), v1 = acc[ai][bj][m][1] + *(const f32x4*)(rp + bj * HALF + 4);
                        u32x4 w; w.x = cvt_pk_bf16(v0[0], v0[1]); w.y = cvt_pk_bf16(v0[2], v0[3]); w.z = cvt_pk_bf16(v1[0], v1[1]); w.w = cvt_pk_bf16(v1[2], v1[3]);
                        *(u32x4*)(ob + (size_t)row * 1024 + colt + cl + bj * HALF) = w;
                        s += (v0[0] * v0[0] + v0[1] * v0[1]) + (v0[2] * v0[2] + v0[3] * v0[3]) + (v1[0] * v1[0] + v1[1] * v1[1]) + (v1[2] * v1[2] + v1[3] * v1[3]); }
                    s += __shfl_xor(s, 16); s += __shfl_xor(s, 32); if (fq == 0) unsafeAtomicAdd(ssq + row, s);
                } else if (MODE == 5 || MODE == 7) {
                    const bf16_t* rp = rb + (size_t)row * 1024 + colt + cl; float s = 0.f;
#pragma unroll
                    for (int bj = 0; bj < 2; ++bj) { const u32x4 rr = *(const u32x4*)(rp + bj * HALF);
                        f32x4 v0 = acc[ai][bj][m][0], v1 = acc[ai][bj][m][1];
                        v0[0] += __uint_as_float(rr.x << 16); v0[1] += __uint_as_float(rr.x & 0xffff0000u); v0[2] += __uint_as_float(rr.y << 16); v0[3] += __uint_as_float(rr.y & 0xffff0000u);
                        v1[0] += __uint_as_float(rr.z << 16); v1[1] += __uint_as_float(rr.z & 0xffff0000u); v1[2] += __uint_as_float(rr.w << 16); v1[3] += __uint_as_float(rr.w & 0xffff0000u);
                        if (MODE == 5) { u32x4 w; w.x = cvt_pk_bf16(v0[0], v0[1]); w.y = cvt_pk_bf16(v0[2], v0[3]); w.z = cvt_pk_bf16(v1[0], v1[1]); w.w = cvt_pk_bf16(v1[2], v1[3]);
                            *(u32x4*)(ob + (size_t)row * 1024 + colt + cl + bj * HALF) = w;
                            s += (v0[0] * v0[0] + v0[1] * v0[1]) + (v0[2] * v0[2] + v0[3] * v0[3]) + (v1[0] * v1[0] + v1[1] * v1[1]) + (v1[2] * v1[2] + v1[3] * v1[3]); }
                        else { float* op = of + (size_t)row * 1024 + colt + cl + bj * HALF; *(f32x4*)op = v0; *(f32x4*)(op + 4) = v1; } }
                    if (MODE == 5) { s += __shfl_xor(s, 16); s += __shfl_xor(s, 32); if (fq == 0) unsafeAtomicAdd(ssq + row, s); }
                } else if (MODE == 3 || MODE == 6) {
                    const float rs = rsv[ai][m]; float s = 0.f;
#pragma unroll
                    for (int bj = 0; bj < 2; ++bj) { f32x4 v0 = acc[ai][bj][m][0] * rs, v1 = acc[ai][bj][m][1] * rs;
                        if (MODE == 6) {
#pragma unroll
                            for (int e = 0; e < 4; ++e) { const float a = fmaxf(v0[e], 0.f), b = fmaxf(v1[e], 0.f); v0[e] = a * a; v1[e] = b * b; } }
                        u32x4 w; w.x = cvt_pk_bf16(v0[0], v0[1]); w.y = cvt_pk_bf16(v0[2], v0[3]); w.z = cvt_pk_bf16(v1[0], v1[1]); w.w = cvt_pk_bf16(v1[2], v1[3]);
                        *(u32x4*)(ob + (size_t)row * ldb + colt + cl + bj * HALF) = w;
                        if (MODE == 3) s += (v0[0] * v0[0] + v0[1] * v0[1]) + (v0[2] * v0[2] + v0[3] * v0[3]) + (v1[0] * v1[0] + v1[1] * v1[1]) + (v1[2] * v1[2] + v1[3] * v1[3]); }
                    if (MODE == 3) { s += __shfl_xor(s, 16); s += __shfl_xor(s, 32); if (fq == 0) unsafeAtomicAdd(ssq + (size_t)row * 4 + u.pn, s); }
                }
            }
    }
};
}
#define LAS __attribute__((address_space(3)))
typedef unsigned short bf16;
typedef unsigned v4u __attribute__((ext_vector_type(4)));
typedef unsigned v2u __attribute__((ext_vector_type(2)));
typedef float f32x4 __attribute__((ext_vector_type(4)));
typedef short bf16x8 __attribute__((ext_vector_type(8)));
typedef short v4i16_t __attribute__((ext_vector_type(4)));

constexpr int T = 49152, TP = 16384, DM = 1024, NMEM = 2560;
constexpr size_t MiB = 1u << 20;
constexpr size_t SLOT = (size_t)T * 512 * 2;
constexpr size_t OFF_WIN = 384 * MiB, OFF_MEMN = 392 * MiB, OFF_KX = 400 * MiB, OFF_VXT = 408 * MiB, OFF_DT = 416 * MiB, OFF_DEC = 420 * MiB;
constexpr size_t OFF_HB2 = 384 * MiB;
constexpr size_t OFF_W1 = 480 * MiB, OFF_W2 = 488 * MiB, OFF_WOUT = 496 * MiB, OFF_WQ = 498 * MiB, OFF_WKV = 500 * MiB, OFF_WO = 504 * MiB, OFF_SSQ = 506 * MiB;
constexpr size_t OFF_BAR = 509 * MiB;
constexpr size_t WS_NEED = 512 * MiB;
constexpr int LDS_BYTES = 147456;
constexpr float EPS = 1e-6f;
constexpr float LOG2E = 1.4426950408889634f;

struct Args { const float* in[26]; float* out; unsigned char* ws; int ph_lo, ph_hi, flags, pad; };

typedef float f32x2_t __attribute__((ext_vector_type(2))); typedef __bf16 bf16x2_t __attribute__((ext_vector_type(2)));
__device__ __forceinline__ unsigned pk2(float lo, float hi) { const f32x2_t v = {lo, hi}; const bf16x2_t b = __builtin_convertvector(v, bf16x2_t); return __builtin_bit_cast(unsigned, b); }
__device__ __forceinline__ unsigned f2bf(float f) { return pk2(f, 0.f) & 0xffffu; }
__device__ __forceinline__ float bflo(unsigned u) { return __uint_as_float(u << 16); }
__device__ __forceinline__ float bfhi(unsigned u) { return __uint_as_float(u & 0xffff0000u); }
__device__ __forceinline__ float bf1(bf16 b) { return __uint_as_float((unsigned)b << 16); }
__device__ __forceinline__ float wave_sum(float v) {
#pragma unroll
    for (int o = 1; o < 64; o <<= 1) v += __shfl_xor(v, o);
    return v; }
__device__ __forceinline__ float wave_max(float v) {
#pragma unroll
    for (int o = 1; o < 64; o <<= 1) v = fmaxf(v, __shfl_xor(v, o));
    return v; }
__device__ __forceinline__ void seq_of(int t, int& start, int& len) { if (t < TP) { start = t & ~8191; len = 8192; } else { start = TP + ((t - TP) & ~4095); len = 4096; } }
#define LDSW() asm volatile("s_waitcnt lgkmcnt(0)" ::: "memory")
#define MFMA16(a, b, c) __builtin_amdgcn_mfma_f32_16x16x32_bf16((a), (b), (c), 0, 0, 0)
__device__ __forceinline__ bf16x8 tr_frag(LAS unsigned char* img, int stride, int rowA, int rowB, int col0, int lane) {
    const int q = (lane & 15) >> 2, pp = lane & 3;
    const v4i16_t a = __builtin_amdgcn_ds_read_tr16_b64_v4i16((LAS v4i16_t*)(img + (rowA + q) * stride + (col0 + 4 * pp) * 2));
    const v4i16_t b = __builtin_amdgcn_ds_read_tr16_b64_v4i16((LAS v4i16_t*)(img + (rowB + q) * stride + (col0 + 4 * pp) * 2));
    return (bf16x8){a[0], a[1], a[2], a[3], b[0], b[1], b[2], b[3]};
}
__device__ __forceinline__ bf16x8 pack8(const f32x4& a, const f32x4& b) { v4u w; w.x = pk2(a[0], a[1]); w.y = pk2(a[2], a[3]); w.z = pk2(b[0], b[1]); w.w = pk2(b[2], b[3]); return __builtin_bit_cast(bf16x8, w); }

__device__ __forceinline__ void p0_transpose_item(const float* W, int ldw, int K, int ncols, bf16* WT, int row_off, const float* g0, const float* g1, LAS float* scr, int item, int lane) {
    const int nblk = ncols / 32, kb = item / nblk, nb = item % nblk, k0 = 64 * kb, n0 = 32 * nb;
#pragma unroll
    for (int i = 0; i < 8; ++i) { const int kk = 8 * i + (lane >> 3), nq = (lane & 7) * 4; const int k = k0 + kk; const float gg = g0 ? (k < 512 ? g0[k] : g1[k - 512]) : 1.0f;
        const f32x4 v = *(const f32x4*)(W + (size_t)k * ldw + n0 + nq);
        scr[kk * 33 + nq] = v[0] * gg; scr[kk * 33 + nq + 1] = v[1] * gg; scr[kk * 33 + nq + 2] = v[2] * gg; scr[kk * 33 + nq + 3] = v[3] * gg; }
    LDSW();
    const int c = lane & 7;
#pragma unroll
    for (int j = 0; j < 4; ++j) { const int n = (lane >> 3) + 8 * j; const LAS float* s = scr + (8 * c) * 33 + n;
        v4u o; o.x = pk2(s[0 * 33], s[1 * 33]); o.y = pk2(s[2 * 33], s[3 * 33]); o.z = pk2(s[4 * 33], s[5 * 33]); o.w = pk2(s[6 * 33], s[7 * 33]);
        *(v4u*)(WT + (size_t)(row_off + n0 + n) * K + k0 + 8 * c) = o; }
    LDSW();
}
template <int NR> __device__ __forceinline__ void rms_rows_to_bf16(const float* const (&xrow)[NR], const f32x4 (&g)[4], bf16* const (&orow)[NR], int lane) {
    f32x4 v[NR][4];
#pragma unroll
    for (int r = 0; r < NR; ++r)
#pragma unroll
        for (int j = 0; j < 4; ++j) v[r][j] = ((const f32x4*)xrow[r])[lane + 64 * j];
#pragma unroll
    for (int r = 0; r < NR; ++r) { float s = 0.f;
#pragma unroll
        for (int j = 0; j < 4; ++j) s += (v[r][j].x * v[r][j].x + v[r][j].y * v[r][j].y) + (v[r][j].z * v[r][j].z + v[r][j].w * v[r][j].w);
        const float rs = 1.0f / sqrtf(wave_sum(s) * (1.0f / 1024.0f) + EPS);
        unsigned long long* o8 = (unsigned long long*)orow[r] + lane;
#pragma unroll
        for (int j = 0; j < 4; ++j) o8[64 * j] = (unsigned long long)pk2(v[r][j].x * rs * g[j].x, v[r][j].y * rs * g[j].y) | ((unsigned long long)pk2(v[r][j].z * rs * g[j].z, v[r][j].w * rs * g[j].w) << 32); }
}
__device__ __forceinline__ void phase_prologue(const Args& A, LAS unsigned char* lds, int tid, int lane, int wave) {
    unsigned char* ws = A.ws;
    LAS float* scr = (LAS float*)(lds + wave * 16384);
    const int G = gridDim.x, gw = blockIdx.x * 8 + wave, NGW = G * 8;
    bf16* Win_t = (bf16*)(ws + OFF_WIN);
    for (int it = gw; it < 8192; it += NGW) {
        int r = it;
        if (r < 768) { p0_transpose_item(A.in[5], 3088, 1024, 1536, Win_t, 0, nullptr, nullptr, scr, r, lane); continue; } r -= 768;
        if (r < 768) { p0_transpose_item(A.in[5] + 1552, 3088, 1024, 1536, Win_t, 1536, nullptr, nullptr, scr, r, lane); continue; } r -= 768;
        if (r < 512) { p0_transpose_item(A.in[15], 1024, 1024, 1024, (bf16*)(ws + OFF_WOUT), 0, A.in[11], A.in[14], scr, r, lane); continue; } r -= 512;
        if (r < 512) { p0_transpose_item(A.in[18], 1024, 1024, 1024, (bf16*)(ws + OFF_WQ), 0, A.in[16], A.in[16] + 512, scr, r, lane); continue; } r -= 512;
        if (r < 1024) { p0_transpose_item(A.in[19], 2048, 1024, 2048, (bf16*)(ws + OFF_WKV), 0, nullptr, nullptr, scr, r, lane); continue; } r -= 1024;
        if (r < 512) { p0_transpose_item(A.in[22], 1024, 1024, 1024, (bf16*)(ws + OFF_WO), 0, nullptr, nullptr, scr, r, lane); continue; } r -= 512;
        if (r < 2048) { p0_transpose_item(A.in[24], 4096, 1024, 4096, (bf16*)(ws + OFF_W1), 0, A.in[23], A.in[23] + 512, scr, r, lane); continue; } r -= 2048;
        p0_transpose_item(A.in[25], 1024, 4096, 1024, (bf16*)(ws + OFF_W2), 0, nullptr, nullptr, scr, r, lane);
    }
    const int gt = blockIdx.x * 512 + tid, NGT = G * 512;
    for (int i = gt; i < 16 * 1024; i += NGT) { const int n = i >> 10, k = i & 1023; Win_t[(size_t)(3072 + n) * 1024 + k] = (bf16)f2bf(A.in[5][(size_t)k * 3088 + 1536 + n]); }
    for (int i = gt; i < 240 * 1024 / 8; i += NGT) ((v4u*)(Win_t + (size_t)3088 * 1024))[i] = (v4u){0u, 0u, 0u, 0u};
    { f32x4* z = (f32x4*)(ws + OFF_SSQ); for (int i = gt; i < T * 8 / 4; i += NGT) z[i] = (f32x4){0.f, 0.f, 0.f, 0.f}; }
    { f32x4 g[4];
#pragma unroll
      for (int j = 0; j < 4; ++j) g[j] = ((const f32x4*)A.in[4])[lane + 64 * j];
      bf16* XN = (bf16*)ws;
      for (int m = gw; m < T; m += 4 * NGW) { const float* xr[4]; bf16* orow[4];
#pragma unroll
          for (int r = 0; r < 4; ++r) { int mm = m + r * NGW; mm = mm < T ? mm : T - 1; xr[r] = mm < TP ? A.in[0] + (size_t)mm * 1024 : A.in[1] + (size_t)(mm - TP) * 1024; orow[r] = XN + (size_t)mm * 1024; }
          rms_rows_to_bf16<4>(xr, g, orow, lane); } }
    { f32x4 g[4];
#pragma unroll
      for (int j = 0; j < 4; ++j) g[j] = ((const f32x4*)A.in[17])[lane + 64 * j];
      bf16* MEMN = (bf16*)(ws + OFF_MEMN);
      for (int m = gw; m < NMEM; m += NGW) { const float* xr[1] = {m < 512 ? A.in[2] + (size_t)m * 1024 : A.in[3] + (size_t)(m - 512) * 1024}; bf16* orow[1] = {MEMN + (size_t)m * 1024}; rms_rows_to_bf16<1>(xr, g, orow, lane); } }
}

__device__ __forceinline__ void load8(const bf16* p, float (&v)[8]) { const v4u u = *(const v4u*)p; v[0] = bflo(u.x); v[1] = bfhi(u.x); v[2] = bflo(u.y); v[3] = bfhi(u.y); v[4] = bflo(u.z); v[5] = bfhi(u.z); v[6] = bflo(u.w); v[7] = bfhi(u.w); }
__device__ __forceinline__ void store8(bf16* p, const float (&v)[8]) { v4u u; u.x = pk2(v[0], v[1]); u.y = pk2(v[2], v[3]); u.z = pk2(v[4], v[5]); u.w = pk2(v[6], v[7]); *(v4u*)p = u; }
__device__ __forceinline__ void phase_elementwise(const Args& A, int tid, int lane) {
    unsigned char* ws = A.ws;
    for (int u = blockIdx.x; u < 1536; u += gridDim.x) {
        if (u < 768) {
            const int ten = u / 384, blk = u % 384, t0 = blk * 128; int ss, L; seq_of(t0, ss, L);
            const bf16* src = (const bf16*)(ws + (3 + ten) * SLOT); bf16* dst = (bf16*)(ws + ten * SLOT);
            const int cgp = tid & 63, tg = tid >> 6, ch = ten * 512 + cgp * 8;
            float w[5][8], b[8];
#pragma unroll
            for (int k = 0; k < 5; ++k)
#pragma unroll
                for (int e = 0; e < 8; ++e) w[k][e] = A.in[6][k * 1024 + ch + e];
#pragma unroll
            for (int e = 0; e < 8; ++e) b[e] = A.in[7][ch + e];
            const int tb = t0 + tg * 16;
            v4u raw[20];
#pragma unroll
            for (int k = 0; k < 20; ++k) { const int tt = tb - 2 + k; raw[k] = (tt >= ss && tt < ss + L) ? *(const v4u*)(src + (size_t)tt * 512 + cgp * 8) : (v4u){0u, 0u, 0u, 0u}; }
#pragma unroll
            for (int i = 0; i < 16; ++i) {
                float o[8];
#pragma unroll
                for (int e = 0; e < 8; ++e) o[e] = b[e];
#pragma unroll
                for (int k = 0; k < 5; ++k) { const v4u q = raw[i + k];
                    o[0] += w[k][0] * bflo(q.x); o[1] += w[k][1] * bfhi(q.x); o[2] += w[k][2] * bflo(q.y); o[3] += w[k][3] * bfhi(q.y);
                    o[4] += w[k][4] * bflo(q.z); o[5] += w[k][5] * bfhi(q.z); o[6] += w[k][6] * bflo(q.w); o[7] += w[k][7] * bfhi(q.w); }
#pragma unroll
                for (int e = 0; e < 8; ++e) o[e] = o[e] * __builtin_amdgcn_rcpf(1.0f + __expf(-o[e]));
                store8(dst + (size_t)(tb + i) * 512 + cgp * 8, o);
            }
        } else {
            const int v = u - 768, ten = v / 384, blk = v % 384, t0 = blk * 128; int ss, L; seq_of(t0, ss, L);
            bf16* X = (bf16*)(ws + (5 + ten) * SLOT); const float* gp = A.in[12 + ten];
            const int c8 = tid & 63, sub = c8 & 7; float g[8];
#pragma unroll
            for (int e = 0; e < 8; ++e) g[e] = gp[sub * 8 + e];
            const float invf1 = exp2f(-(float)sub * 0.125f * 18.931568569324174f);
            v4u rq[16];
#pragma unroll
            for (int it = 0; it < 16; ++it) rq[it] = *(const v4u*)(X + (size_t)(t0 + it * 8 + (tid >> 6)) * 512 + c8 * 8);
#pragma unroll
            for (int it = 0; it < 16; ++it) {
                const int tok = t0 + it * 8 + (tid >> 6); bf16* p = X + (size_t)tok * 512 + c8 * 8; float x[8];
                { const v4u q = rq[it]; x[0] = bflo(q.x); x[1] = bfhi(q.x); x[2] = bflo(q.y); x[3] = bfhi(q.y); x[4] = bflo(q.z); x[5] = bfhi(q.z); x[6] = bflo(q.w); x[7] = bfhi(q.w); }
                float s = 0.f;
#pragma unroll
                for (int e = 0; e < 8; ++e) s += x[e] * x[e];
                s += __shfl_xor(s, 1); s += __shfl_xor(s, 2); s += __shfl_xor(s, 4);
                const float rs = 1.0f / sqrtf(s * (1.0f / 64.0f) + EPS);
#pragma unroll
                for (int e = 0; e < 8; ++e) x[e] = x[e] * rs * g[e];
                float o[8]; const float pos = (float)(tok - ss);
                float sn1, cs1;
                { const float ang = pos * invf1; const double rev = (double)ang * 0.15915494309189535; const float fr = (float)(rev - rint(rev)); sn1 = __builtin_amdgcn_sinf(fr); cs1 = __builtin_amdgcn_cosf(fr); }
#pragma unroll
                for (int e = 0; e < 8; ++e) { const float other = __shfl_xor(x[e], 1); const float sn = __shfl(sn1, (lane & ~7) + e), cs = __shfl(cs1, (lane & ~7) + e);
                    o[e] = sub == 0 ? x[e] * cs - other * sn : (sub == 1 ? x[e] * cs + other * sn : x[e]); }
                store8(p, o);
            }
        }
    }
}
__device__ __forceinline__ void phase_kxnorm(const Args& A, int tid) {
    unsigned char* ws = A.ws;
    for (int u = blockIdx.x; u < 640; u += gridDim.x) {
        {
            const int v = u; const int item = v * 16 + (tid >> 5), l5 = tid & 31; const int row = item >> 2, hd = item & 3;
            bf16* p = (bf16*)(ws + OFF_KX) + (size_t)row * 1024 + hd * 256 + l5 * 8; float x[8]; load8(p, x);
            float s = 0.f;
#pragma unroll
            for (int e = 0; e < 8; ++e) s += x[e] * x[e];
            s += __shfl_xor(s, 1); s += __shfl_xor(s, 2); s += __shfl_xor(s, 4); s += __shfl_xor(s, 8); s += __shfl_xor(s, 16);
            const float rs = 1.0f / sqrtf(s * (1.0f / 256.0f) + EPS);
#pragma unroll
            for (int e = 0; e < 8; ++e) x[e] = x[e] * rs * A.in[21][l5 * 8 + e] * A.in[20][l5 * 8 + e];
            store8(p, x);
        }
    }
}
#define XB_TMO      128
#define XB_XCNT(j)  (256  + 64 * (j))
#define XB_XSUB(j)  (1280 + 64 * (j))
#define XB_XGEN(j)  (2304 + 64 * (j))
#define XB_TOP      3328
#define XB_TOPGEN   3392
#define XCD_BAR_WORDS 3456
#define XB_SPIN_CAP (1u << 18)

__device__ __forceinline__ unsigned xb_ld(unsigned* p)              { return __hip_atomic_load(p, __ATOMIC_RELAXED, __HIP_MEMORY_SCOPE_AGENT); }
__device__ __forceinline__ unsigned xb_add(unsigned* p, unsigned v) { return __hip_atomic_fetch_add(p, v, __ATOMIC_RELAXED, __HIP_MEMORY_SCOPE_AGENT); }
__device__ __forceinline__ unsigned xb_xcc_id() { return (unsigned)__builtin_amdgcn_s_getreg((3 << 11) | 20) & 0xFu; }
#define XB_SPIN(cond, bar) do { unsigned _sp = 0; while (cond) { __builtin_amdgcn_s_sleep(1); \
    if ((++_sp & 255u) == 0u) { if (xb_ld(&(bar)[XB_TMO])) break; if (_sp > XB_SPIN_CAP) { atomicAdd(&(bar)[XB_TMO], 1u); break; } } } } while (0)

struct XcdBarrier {
    unsigned* bar; unsigned x;
    volatile LAS unsigned* st;
};

__device__ __forceinline__ XcdBarrier xcd_barrier_post(unsigned* bar, volatile LAS unsigned* st) {
    XcdBarrier b; b.bar = bar; b.x = xb_xcc_id(); b.st = st;
    if (threadIdx.x == 0) st[4] = xb_add(&bar[XB_XCNT(b.x)], 1u);
    return b;
}
__device__ __forceinline__ void xcd_barrier_complete(unsigned* bar, unsigned x, unsigned& nloc, unsigned& nx) {
    const unsigned G = gridDim.x * gridDim.y * gridDim.z;
    unsigned sum, cnt, mine, sp = 0u;
    for (;;) {
        sum = 0u; cnt = 0u; mine = 0u;
#pragma unroll
        for (unsigned j = 0; j < 16; ++j) { const unsigned c = xb_ld(&bar[XB_XCNT(j)]); sum += c; cnt += (c > 0u) ? 1u : 0u; mine = (j == x) ? c : mine; }
        if (sum == G) break;
        __builtin_amdgcn_s_sleep(1);
        if ((++sp & 255u) == 0u) { if (xb_ld(&bar[XB_TMO])) break; if (sp > XB_SPIN_CAP) { atomicAdd(&bar[XB_TMO], 1u); break; } }
    }
    nloc = mine > 0u ? mine : 1u; nx = cnt > 0u ? cnt : 1u;
}

__device__ __forceinline__ void xcd_barrier(const XcdBarrier& b) {
    asm volatile("s_waitcnt vmcnt(0)" ::: "memory");
    __syncthreads();
    if (threadIdx.x == 0) {
        unsigned* bar = b.bar;
        __builtin_amdgcn_s_waitcnt(0);
        unsigned nloc = b.st[0], nx = b.st[1];
        if (nloc == 0u) { xcd_barrier_complete(bar, b.x, nloc, nx); b.st[0] = nloc; b.st[1] = nx; }
        const unsigned old = xb_add(&bar[XB_XSUB(b.x)], 1u);
        const unsigned gen = old / nloc;
        if (old + 1u == (gen + 1u) * nloc) {
            __builtin_amdgcn_fence(__ATOMIC_RELEASE, "agent");
            asm volatile("s_waitcnt vmcnt(0)" ::: "memory");
            const unsigned og = xb_add(&bar[XB_TOP], 1u);
            const unsigned tg = og / nx;
            if (og + 1u == (tg + 1u) * nx) xb_add(&bar[XB_TOPGEN], 1u);
            else XB_SPIN(xb_ld(&bar[XB_TOPGEN]) == tg, bar);
            __builtin_amdgcn_fence(__ATOMIC_ACQUIRE, "agent");
            xb_add(&bar[XB_XGEN(b.x)], 1u);
            asm volatile("s_waitcnt vmcnt(0)" ::: "memory");
        } else {
            XB_SPIN(xb_ld(&bar[XB_XGEN(b.x)]) == gen, bar);
            __builtin_amdgcn_fence(__ATOMIC_ACQUIRE, "agent");
            asm volatile("s_waitcnt vmcnt(0)" ::: "memory");
        }
    }
    __syncthreads();
}
constexpr int L_VDT = 0, L_VCUM = 4096, L_VTOT = 8192, L_BIMG = 9216, BSTR = 272, XSTR = 144;
constexpr int L_XF = L_BIMG + 128 * BSTR  , L_XB = L_XF + 128 * XSTR  ;
constexpr int L_CIMG = L_BIMG + 128 * BSTR  , L_XIMG = L_CIMG + 128 * BSTR  , L_PIMG = L_XIMG + 128 * XSTR  ;
__device__ __forceinline__ void ssd_vectors(const Args& A, LAS unsigned char* lds, int t0, int g, int wave, int lane) {
    const int hh = wave >> 1, dir = wave & 1, head = 4 * g + hh;
    const float* DT = (const float*)(A.ws + OFF_DT);
    const float bias = A.in[9][dir * 8 + head], Aneg = -__expf(A.in[8][dir * 8 + head]);
    float d[2], a[2];
#pragma unroll
    for (int k = 0; k < 2; ++k) { const float x = DT[(size_t)(t0 + 2 * lane + k) * 16 + dir * 8 + head] + bias; d[k] = x > 20.f ? x : log1pf(__expf(x)); a[k] = d[k] * Aneg; }
    const float ps = a[0] + a[1]; float inc = ps;
#pragma unroll
    for (int o = 1; o < 64; o <<= 1) { const float y = __shfl_up(inc, o); if (lane >= o) inc += y; }
    const float exc = inc - ps; const float tot = __shfl(inc, 63);
    LAS float* vdt = (LAS float*)(lds + L_VDT) + (hh * 2 + dir) * 128; LAS float* vc = (LAS float*)(lds + L_VCUM) + (hh * 2 + dir) * 128;
    vdt[2 * lane] = d[0]; vdt[2 * lane + 1] = d[1];
    if (dir == 0) { vc[2 * lane] = exc + a[0]; vc[2 * lane + 1] = inc; } else { vc[2 * lane] = exc; vc[2 * lane + 1] = exc + a[0]; }
    if (lane == 0) ((LAS float*)(lds + L_VTOT))[hh * 2 + dir] = tot;
}
__device__ __forceinline__ void stage_rows128(const bf16* src, int ld, LAS unsigned char* img, int tid) {
#pragma unroll
    for (int i = 0; i < 4; ++i) { const int idx = tid + 512 * i, row = idx >> 4, ch = idx & 15; *(LAS v4u*)(img + row * BSTR + ch * 16) = *(const v4u*)(src + (size_t)row * ld + ch * 8); }
}
__device__ __forceinline__ void ssd_states_unit(const Args& A, LAS unsigned char* lds, int c, int g, int tid, int lane, int wave) {
    unsigned char* ws = A.ws; const int t0 = c * 128;
    const bf16* XS = (const bf16*)ws; const bf16* BC = (const bf16*)(ws + SLOT); bf16* ST = (bf16*)A.out;
    v4u xall[4][2];
#pragma unroll
    for (int hh = 0; hh < 4; ++hh)
#pragma unroll
        for (int h2 = 0; h2 < 2; ++h2) xall[hh][h2] = *(const v4u*)(XS + (size_t)(t0 + (tid >> 2)) * 512 + (4 * g + hh) * 64 + (tid & 3) * 16 + 8 * h2);
    ssd_vectors(A, lds, t0, g, wave, lane);
    stage_rows128(BC + (size_t)t0 * 512 + g * 128, 512, lds + L_BIMG, tid);
    LDSW(); __syncthreads();
    if (tid < 8) ((float*)(ws + OFF_DEC))[(c * 8 + 4 * g + (tid >> 1)) * 2 + (tid & 1)] = __expf(((LAS float*)(lds + L_VTOT))[tid]);
    const int kg = lane >> 4;
#pragma unroll
    for (int hh = 0; hh < 4; ++hh) {
        const int head = 4 * g + hh;
        { const int j = tid >> 2, c0 = (tid & 3) * 16; const LAS float* vdt = (LAS float*)(lds + L_VDT) + hh * 256; const LAS float* vc = (LAS float*)(lds + L_VCUM) + hh * 256;
          const float wf = __expf(fminf(((LAS float*)(lds + L_VTOT))[hh * 2] - vc[j], 0.f)) * vdt[j], wb = __expf(fminf(vc[128 + j], 0.f)) * vdt[128 + j];
#pragma unroll
          for (int h2 = 0; h2 < 2; ++h2) { float x[8]; { const v4u q = xall[hh][h2]; x[0] = bflo(q.x); x[1] = bfhi(q.x); x[2] = bflo(q.y); x[3] = bfhi(q.y); x[4] = bflo(q.z); x[5] = bfhi(q.z); x[6] = bflo(q.w); x[7] = bfhi(q.w); } v4u f, b;
              f.x = pk2(x[0] * wf, x[1] * wf); f.y = pk2(x[2] * wf, x[3] * wf); f.z = pk2(x[4] * wf, x[5] * wf); f.w = pk2(x[6] * wf, x[7] * wf);
              b.x = pk2(x[0] * wb, x[1] * wb); b.y = pk2(x[2] * wb, x[3] * wb); b.z = pk2(x[4] * wb, x[5] * wb); b.w = pk2(x[6] * wb, x[7] * wb);
              *(LAS v4u*)(lds + L_XF + j * XSTR + (c0 + 8 * h2) * 2) = f; *(LAS v4u*)(lds + L_XB + j * XSTR + (c0 + 8 * h2) * 2) = b; } }
        LDSW(); __syncthreads();
        const int dir = wave >> 2, nt0 = (wave & 3) * 2; LAS unsigned char* ximg = lds + (dir ? L_XB : L_XF);
        f32x4 acc[4][2];
#pragma unroll
        for (int pt = 0; pt < 4; ++pt)
#pragma unroll
            for (int nt = 0; nt < 2; ++nt) acc[pt][nt] = (f32x4){0.f, 0.f, 0.f, 0.f};
#pragma unroll
        for (int ks = 0; ks < 4; ++ks) {
            bf16x8 af[4], bfr[2]; const int r0 = 32 * ks + 8 * kg;
#pragma unroll
            for (int pt = 0; pt < 4; ++pt) af[pt] = tr_frag(ximg, XSTR, r0, r0 + 4, 16 * pt, lane);
#pragma unroll
            for (int nt = 0; nt < 2; ++nt) bfr[nt] = tr_frag(lds + L_BIMG, BSTR, r0, r0 + 4, 16 * (nt0 + nt), lane);
#pragma unroll
            for (int pt = 0; pt < 4; ++pt)
#pragma unroll
                for (int nt = 0; nt < 2; ++nt) acc[pt][nt] = MFMA16(af[pt], bfr[nt], acc[pt][nt]);
        }
        bf16* sp = ST + (size_t)((c * 8 + head) * 2 + dir) * 8192;
#pragma unroll
        for (int pt = 0; pt < 4; ++pt)
#pragma unroll
            for (int nt = 0; nt < 2; ++nt)
#pragma unroll
                for (int e = 0; e < 4; ++e) sp[(16 * pt + 4 * kg + e) * 128 + 16 * (nt0 + nt) + (lane & 15)] = (bf16)f2bf(acc[pt][nt][e]);
        LDSW(); __syncthreads();
    }
}
template <int NV> __device__ __forceinline__ void scan_task(bf16* ST, const float* DEC, int c0, int nc, int head, int dir, int eoff) {
    float carry[8 * NV];
#pragma unroll
    for (int e = 0; e < 8 * NV; ++e) carry[e] = 0.f;
    for (int k = 0; k < nc; k += 8) {
        v4u sv[8][NV]; float dc[8];
#pragma unroll
        for (int u = 0; u < 8; ++u) { const int c = dir ? c0 + nc - 1 - (k + u) : c0 + k + u; const bf16* p = ST + (size_t)((c * 8 + head) * 2 + dir) * 8192 + eoff;
#pragma unroll
            for (int h = 0; h < NV; ++h) sv[u][h] = *(const v4u*)(p + 8 * h);
            dc[u] = DEC[(c * 8 + head) * 2 + dir]; }
#pragma unroll
        for (int u = 0; u < 8; ++u) { const int c = dir ? c0 + nc - 1 - (k + u) : c0 + k + u; bf16* p = ST + (size_t)((c * 8 + head) * 2 + dir) * 8192 + eoff;
#pragma unroll
            for (int h = 0; h < NV; ++h) { v4u o; o.x = pk2(carry[8 * h], carry[8 * h + 1]); o.y = pk2(carry[8 * h + 2], carry[8 * h + 3]); o.z = pk2(carry[8 * h + 4], carry[8 * h + 5]); o.w = pk2(carry[8 * h + 6], carry[8 * h + 7]); *(v4u*)(p + 8 * h) = o;
                const v4u s_ = sv[u][h]; const float d = dc[u];
                carry[8 * h] = carry[8 * h] * d + bflo(s_.x); carry[8 * h + 1] = carry[8 * h + 1] * d + bfhi(s_.x); carry[8 * h + 2] = carry[8 * h + 2] * d + bflo(s_.y); carry[8 * h + 3] = carry[8 * h + 3] * d + bfhi(s_.y);
                carry[8 * h + 4] = carry[8 * h + 4] * d + bflo(s_.z); carry[8 * h + 5] = carry[8 * h + 5] * d + bfhi(s_.z); carry[8 * h + 6] = carry[8 * h + 6] * d + bflo(s_.w); carry[8 * h + 7] = carry[8 * h + 7] * d + bfhi(s_.w); } }
    }
}
__device__ __forceinline__ void phase_scan(const Args& A, int tid) {
    bf16* ST = (bf16*)A.out; const float* DEC = (const float*)(A.ws + OFF_DEC);
    for (int idx = blockIdx.x * 512 + tid; idx < 98304; idx += gridDim.x * 512) {
        if (idx < 32768) { const int e8 = idx & 1023, dir = (idx >> 10) & 1, head = (idx >> 11) & 7, sq = idx >> 14; scan_task<1>(ST, DEC, sq * 64, 64, head, dir, e8 * 8); }
        else { const int j = idx - 32768; const int e16 = j & 511, dir = (j >> 9) & 1, head = (j >> 10) & 7, sq = j >> 13; scan_task<2>(ST, DEC, 128 + sq * 32, 32, head, dir, e16 * 16); }
    }
}
__device__ __forceinline__ void ssd_out_unit(const Args& A, LAS unsigned char* lds, int c, int g, int tid, int lane, int wave) {
    unsigned char* ws = A.ws; const int t0 = c * 128;
    const bf16* XS = (const bf16*)ws; const bf16* BC = (const bf16*)(ws + SLOT); const bf16* Z = (const bf16*)(ws + 2 * SLOT); const bf16* ST = (const bf16*)A.out;
    bf16* MIX = (bf16*)(ws + 3 * SLOT); float* ssq = (float*)(ws + OFF_SSQ) + (size_t)T * 6;
    ssd_vectors(A, lds, t0, g, wave, lane);
    stage_rows128(BC + (size_t)t0 * 512 + g * 128, 512, lds + L_BIMG, tid);
    stage_rows128(BC + (size_t)t0 * 512 + 256 + g * 128, 512, lds + L_CIMG, tid);
    LDSW(); __syncthreads();
    const int kg = lane >> 4, l15 = lane & 15, il = 16 * wave + l15;
    bf16x8 cf[4];
#pragma unroll
    for (int ks = 0; ks < 4; ++ks) cf[ks] = *(const LAS bf16x8*)(lds + L_CIMG + il * BSTR + (32 * ks + 8 * kg) * 2);
    f32x4 cb[8];
#pragma unroll
    for (int jt = 0; jt < 8; ++jt) { cb[jt] = (f32x4){0.f, 0.f, 0.f, 0.f};
#pragma unroll
        for (int ks = 0; ks < 4; ++ks) { const bf16x8 bf_ = *(const LAS bf16x8*)(lds + L_BIMG + (16 * jt + l15) * BSTR + (32 * ks + 8 * kg) * 2); cb[jt] = MFMA16(bf_, cf[ks], cb[jt]); } }
    float ssqa[4] = {0.f, 0.f, 0.f, 0.f};
    v4u xr[2], pr[4];
    {
#pragma unroll
        for (int i = 0; i < 2; ++i) { const int idx = tid + 512 * i, row = idx >> 3, ch = idx & 7; xr[i] = *(const v4u*)(XS + (size_t)(t0 + row) * 512 + (4 * g) * 64 + ch * 8); }
        const bf16* sp = ST + (size_t)((c * 8 + 4 * g) * 2) * 8192;
#pragma unroll
        for (int i = 0; i < 4; ++i) pr[i] = *(const v4u*)(sp + (size_t)(tid + 512 * i) * 8);
    }
    for (int hh = 0; hh < 4; ++hh) {
        const int head = 4 * g + hh;
        bf16 zr[4][4];
        __syncthreads();
#pragma unroll
        for (int e = 0; e < 4; ++e)
#pragma unroll
            for (int pt = 0; pt < 4; ++pt) zr[e][pt] = Z[(size_t)(t0 + 16 * wave + 4 * kg + e) * 512 + head * 64 + 16 * pt + l15];
#pragma unroll
        for (int i = 0; i < 2; ++i) { const int idx = tid + 512 * i, row = idx >> 3, ch = idx & 7; *(LAS v4u*)(lds + L_XIMG + row * XSTR + ch * 16) = xr[i]; }
#pragma unroll
        for (int i = 0; i < 4; ++i) { const int idx = tid + 512 * i, row = idx >> 4, ch = idx & 15; *(LAS v4u*)(lds + L_PIMG + row * BSTR + ch * 16) = pr[i]; }
        if (hh < 3) {
#pragma unroll
            for (int i = 0; i < 2; ++i) { const int idx = tid + 512 * i, row = idx >> 3, ch = idx & 7; xr[i] = *(const v4u*)(XS + (size_t)(t0 + row) * 512 + (head + 1) * 64 + ch * 8); }
            const bf16* sp = ST + (size_t)((c * 8 + head + 1) * 2) * 8192;
#pragma unroll
            for (int i = 0; i < 4; ++i) pr[i] = *(const v4u*)(sp + (size_t)(tid + 512 * i) * 8);
        }
        LDSW(); __syncthreads();
        const LAS float* vdtf = (LAS float*)(lds + L_VDT) + hh * 256; const LAS float* vdtb = vdtf + 128;
        const LAS float* vcf = (LAS float*)(lds + L_VCUM) + hh * 256; const LAS float* vcb = vcf + 128;
        const float acf_i = vcf[il], ecb_i = vcb[il], Dh = A.in[10][head], totb = ((LAS float*)(lds + L_VTOT))[hh * 2 + 1];
        f32x4 Y[4];
#pragma unroll
        for (int pt = 0; pt < 4; ++pt) Y[pt] = (f32x4){0.f, 0.f, 0.f, 0.f};
#pragma unroll
        for (int ks = 0; ks < 4; ++ks) {
            f32x4 wv[2];
#pragma unroll
            for (int h2 = 0; h2 < 2; ++h2) { const int jt = 2 * ks + h2, j0 = 16 * jt + 4 * kg;
                const f32x4 cfj = *(const LAS f32x4*)(vcf + j0), dfj = *(const LAS f32x4*)(vdtf + j0), cbj = *(const LAS f32x4*)(vcb + j0), dbj = *(const LAS f32x4*)(vdtb + j0);
                if (jt < wave) {
#pragma unroll
                    for (int e = 0; e < 4; ++e) wv[h2][e] = cb[jt][e] * (__expf(fminf(acf_i - cfj[e], 0.f)) * dfj[e]);
                } else if (jt > wave) {
#pragma unroll
                    for (int e = 0; e < 4; ++e) wv[h2][e] = cb[jt][e] * (__expf(fminf(cbj[e] - ecb_i, 0.f)) * dbj[e]);
                } else {
#pragma unroll
                    for (int e = 0; e < 4; ++e) { const int j = j0 + e;
                        const float mf = j <= il ? __expf(fminf(acf_i - cfj[e], 0.f)) * dfj[e] : 0.f, mb = j >= il ? __expf(fminf(cbj[e] - ecb_i, 0.f)) * dbj[e] : 0.f;
                        wv[h2][e] = cb[jt][e] * (mf + mb) + (j == il ? Dh : 0.f); } } }
            const bf16x8 wf = pack8(wv[0], wv[1]);
#pragma unroll
            for (int pt = 0; pt < 4; ++pt) { const bf16x8 xf = tr_frag(lds + L_XIMG, XSTR, 32 * ks + 4 * kg, 32 * ks + 16 + 4 * kg, 16 * pt, lane); Y[pt] = MFMA16(wf, xf, Y[pt]); }
        }
#pragma unroll
        for (int dir = 0; dir < 2; ++dir) {
            f32x4 a2[4];
#pragma unroll
            for (int pt = 0; pt < 4; ++pt) a2[pt] = (f32x4){0.f, 0.f, 0.f, 0.f};
#pragma unroll
            for (int ks = 0; ks < 4; ++ks)
#pragma unroll
                for (int pt = 0; pt < 4; ++pt) { const bf16x8 pf = *(const LAS bf16x8*)(lds + L_PIMG + (dir * 64 + 16 * pt + l15) * BSTR + (32 * ks + 8 * kg) * 2); a2[pt] = MFMA16(cf[ks], pf, a2[pt]); }
            const f32x4 cv = *(const LAS f32x4*)((dir ? vcb : vcf) + 16 * wave + 4 * kg);
#pragma unroll
            for (int e = 0; e < 4; ++e) { const float sc = dir ? __expf(fminf(totb - cv[e], 0.f)) : __expf(fminf(cv[e], 0.f));
#pragma unroll
                for (int pt = 0; pt < 4; ++pt) Y[pt][e] += sc * a2[pt][e]; }
        }
#pragma unroll
        for (int e = 0; e < 4; ++e) { const size_t tok = (size_t)(t0 + 16 * wave + 4 * kg + e);
#pragma unroll
            for (int pt = 0; pt < 4; ++pt) { const int col = head * 64 + 16 * pt + l15; const float z = bf1(zr[e][pt]); const float y = Y[pt][e] * z * __builtin_amdgcn_rcpf(1.0f + __expf(-z));
                ssqa[e] += y * y; MIX[tok * 1024 + col] = (bf16)f2bf(y); } }
    }
#pragma unroll
    for (int e = 0; e < 4; ++e) { float s = ssqa[e]; s += __shfl_xor(s, 1); s += __shfl_xor(s, 2); s += __shfl_xor(s, 4); s += __shfl_xor(s, 8);
        if (l15 == 0) unsafeAtomicAdd(ssq + t0 + 16 * wave + 4 * kg + e, s); }
    __syncthreads();
}
constexpr int L_ACC = 0, ACCSTR = 272, L_DEN = 256 * ACCSTR  , L_VST = L_DEN + 1024  , VSTR = 144, VST_BYTES = 32 * VSTR;
struct DG { int dsh, r, m0, Lc, mtl; };
__device__ __forceinline__ DG dgeom(int task, int wave, int tb, int ss, int L) {
    DG g; const int pi = task < 2 ? task : 2; g.dsh = 2 * pi; const int qt = 2 * wave + (task == 3 ? 1 : 0); const int tsh = 4 - g.dsh;
    g.r = qt >> tsh; const int mt = qt & ((1 << tsh) - 1); g.mtl = 16 * mt; g.m0 = ((tb - ss) >> g.dsh) + g.mtl; g.Lc = L >> g.dsh; return g; }
__device__ __forceinline__ void dkload(const bf16* K, int head, int ss, const DG& g, int c, int lane, bf16x8 (&kk)[4]) {
    const int kg = lane >> 4, l15 = lane & 15;
#pragma unroll
    for (int t = 0; t < 2; ++t) { int mk = g.m0 - 64 + 32 * c + 16 * t + l15; mk = mk < 0 ? 0 : (mk > g.Lc - 1 ? g.Lc - 1 : mk); const unsigned ko = (unsigned)(((ss + (mk << g.dsh) + g.r) * 512 + head * 64 + 8 * kg) * 2);
        kk[2 * t] = *(const bf16x8*)((const char*)K + ko); kk[2 * t + 1] = *(const bf16x8*)((const char*)K + ko + 64); }
}
template <bool TWO, bool HASNEXT> __device__ __forceinline__ void dtask(const bf16* Q, const bf16* K, const bf16* V, int head, int ss, const DG& g, const DG& gn, bf16x8 (&kk)[5][4], bf16x8 (&kn)[5][4],
                                                                        LAS unsigned char* lds, LAS unsigned char* vst, float c1, float c2, int lane) {
    constexpr int NQ = TWO ? 2 : 1; const int kg = lane >> 4, l15 = lane & 15;
    bf16x8 qf[NQ][2];
#pragma unroll
    for (int j = 0; j < NQ; ++j) { const int tokq = ss + ((g.m0 + 16 * j + l15) << g.dsh) + g.r;
#pragma unroll
        for (int ks = 0; ks < 2; ++ks) qf[j][ks] = *(const bf16x8*)((const char*)Q + (unsigned)((tokq * 512 + head * 64 + 32 * ks + 8 * kg) * 2)); }
    float den[NQ]; f32x4 O[NQ][4];
#pragma unroll
    for (int j = 0; j < NQ; ++j) { den[j] = 0.f;
#pragma unroll
        for (int dt = 0; dt < 4; ++dt) O[j][dt] = (f32x4){0.f, 0.f, 0.f, 0.f}; }
#pragma unroll
    for (int grp = 0; grp < 3; ++grp) {
        const int cb = grp * 2, ce = grp == 2 ? 5 : cb + 2;
        bf16x8 kq[2][4]; bf16x8 pf[2][NQ]; v4u vv[2][4];
#pragma unroll
        for (int c = cb; c < ce; ++c) dkload(K, head, ss, g, c, lane, kq[c - cb]);
#pragma unroll
        for (int c = cb; c < ce; ++c) {
            const int kb = g.m0 - 64 + 32 * c;
#pragma unroll
            for (int j = 0; j < NQ; ++j) { f32x4 st[2]; const int mq = g.m0 + 16 * j + l15; const int klo = mq - 64 > 0 ? mq - 64 : 0, khi = mq + 64 < g.Lc - 1 ? mq + 64 : g.Lc - 1; const unsigned kspan = (unsigned)(khi - klo);
#pragma unroll
                for (int t = 0; t < 2; ++t) { st[t] = MFMA16(kq[c - cb][2 * t], qf[j][0], ((f32x4){0.f, 0.f, 0.f, 0.f})); st[t] = MFMA16(kq[c - cb][2 * t + 1], qf[j][1], st[t]); }
#pragma unroll
                for (int t = 0; t < 2; ++t)
#pragma unroll
                    for (int e = 0; e < 4; ++e) { const int mk = kb + 16 * t + 4 * kg + e; const bool ok = (unsigned)(mk - klo) <= kspan;
                        const float p = ok ? __builtin_amdgcn_exp2f(st[t][e] * c1 - c2) : 0.f; st[t][e] = p; den[j] += p; }
                pf[c - cb][j] = pack8(st[0], st[1]); }
        }
        asm volatile("" ::: "memory");
#pragma unroll
        for (int c = cb; c < ce; ++c) {
            const int kb = g.m0 - 64 + 32 * c;
#pragma unroll
            for (int i = 0; i < 4; ++i) { int mk = kb + (lane >> 3) + 8 * i; mk = mk < 0 ? 0 : (mk > g.Lc - 1 ? g.Lc - 1 : mk); vv[c - cb][i] = *(const v4u*)((const char*)V + (unsigned)(((ss + (mk << g.dsh) + g.r) * 512 + head * 64 + 8 * (lane & 7)) * 2)); }
        }
#pragma unroll
        for (int c = cb; c < ce; ++c) {
            LDSW();
#pragma unroll
            for (int i = 0; i < 4; ++i) *(LAS v4u*)(vst + ((lane >> 3) + 8 * i) * VSTR + (lane & 7) * 16) = vv[c - cb][i];
            LDSW();
#pragma unroll
            for (int dt = 0; dt < 4; ++dt) { const bf16x8 vf = tr_frag(vst, VSTR, 4 * kg, 16 + 4 * kg, 16 * dt, lane);
#pragma unroll
                for (int j = 0; j < NQ; ++j) O[j][dt] = MFMA16(vf, pf[c - cb][j], O[j][dt]); }
        }
    }
#pragma unroll
    for (int j = 0; j < NQ; ++j) { float d = den[j]; d += __shfl_xor(d, 16); d += __shfl_xor(d, 32);
        const int tl = ((g.mtl + 16 * j + l15) << g.dsh) + g.r;
#pragma unroll
        for (int dt = 0; dt < 4; ++dt) { LAS f32x4* ap = (LAS f32x4*)(lds + L_ACC + tl * ACCSTR + (16 * dt + 4 * kg) * 4); *ap = *ap + O[j][dt]; }
        if (kg == 0) { LAS float* dp = (LAS float*)(lds + L_DEN) + tl; *dp = *dp + d; } }
}
#define DBAR() do { LDSW(); __builtin_amdgcn_s_barrier(); asm volatile("" ::: "memory"); } while (0)
constexpr int GSTR = 144;
template <int HPC> __device__ __forceinline__ void dstage(const bf16* X, int head, int ss, int Lc, int dsh, int ra, int mbase, LAS unsigned char* img, int row0, int tid) {
    v4u v[6];
#pragma unroll
    for (int i = 0; i < 6; ++i) { const int idx = tid + 512 * i, row = idx >> 3, ch = idx & 7; const int cls = row / HPC; int mk = mbase + (row - cls * HPC); mk = mk < 0 ? 0 : (mk > Lc - 1 ? Lc - 1 : mk);
        v[i] = *(const v4u*)((const char*)X + (unsigned)(((ss + (mk << dsh) + ra + cls) * 512 + head * 64 + ch * 8) * 2)); }
#pragma unroll
    for (int i = 0; i < 6; ++i) { const int idx = tid + 512 * i, row = idx >> 3, ch = idx & 7; *(LAS v4u*)(img + (row0 + row) * GSTR + ch * 16) = v[i]; }
}
template <int NQ> __device__ __forceinline__ void dfused(const bf16* Q, int head, int ss, const DG& g, int krow0, LAS unsigned char* img, float c1, float c2, int lane, f32x4 (&O)[NQ][4], float (&den)[NQ]) {
    const int kg = lane >> 4, l15 = lane & 15;
    bf16x8 qf[NQ][2]; unsigned klo[NQ], kspan[NQ];
#pragma unroll
    for (int j = 0; j < NQ; ++j) { const int mq = g.m0 + 16 * j + l15; const int tokq = ss + (mq << g.dsh) + g.r;
#pragma unroll
        for (int ks = 0; ks < 2; ++ks) qf[j][ks] = *(const bf16x8*)((const char*)Q + (unsigned)((tokq * 512 + head * 64 + 32 * ks + 8 * kg) * 2));
        const int lo = mq - 64 > 0 ? mq - 64 : 0, hi = mq + 64 < g.Lc - 1 ? mq + 64 : g.Lc - 1; klo[j] = (unsigned)lo; kspan[j] = (unsigned)(hi - lo); den[j] = 0.f;
#pragma unroll
        for (int dt = 0; dt < 4; ++dt) O[j][dt] = (f32x4){0.f, 0.f, 0.f, 0.f}; }
#pragma unroll 1
    for (int c = 0; c < 5; ++c) {
        const int kb = g.m0 - 64 + 32 * c; const int row = krow0 + 32 * c;
        const int t1 = (NQ == 1 && c == 4) ? 0 : 16;
        bf16x8 kf[2][2];
#pragma unroll
        for (int t = 0; t < 2; ++t) { const LAS unsigned char* kp = img + (row + t1 * t + l15) * GSTR + kg * 16; kf[t][0] = *(const LAS bf16x8*)kp; kf[t][1] = *(const LAS bf16x8*)(kp + 64); }
        bf16x8 pf[NQ];
#pragma unroll
        for (int j = 0; j < NQ; ++j) { f32x4 st[2];
#pragma unroll
            for (int t = 0; t < 2; ++t) { st[t] = MFMA16(kf[t][0], qf[j][0], ((f32x4){0.f, 0.f, 0.f, 0.f})); st[t] = MFMA16(kf[t][1], qf[j][1], st[t]); }
#pragma unroll
            for (int t = 0; t < 2; ++t)
#pragma unroll
                for (int e = 0; e < 4; ++e) { const int mk = kb + 16 * t + 4 * kg + e; const bool ok = ((unsigned)mk - klo[j]) <= kspan[j];
                    const float p = ok ? __builtin_amdgcn_exp2f(st[t][e] * c1 - c2) : 0.f; st[t][e] = p; den[j] += p; }
            pf[j] = pack8(st[0], st[1]); }
#pragma unroll
        for (int dt = 0; dt < 4; ++dt) { const bf16x8 vf = tr_frag(img, GSTR, 384 + row + 4 * kg, 384 + row + t1 + 4 * kg, 16 * dt, lane);
#pragma unroll
            for (int j = 0; j < NQ; ++j) O[j][dt] = MFMA16(vf, pf[j], O[j][dt]); }
    }
#pragma unroll
    for (int j = 0; j < NQ; ++j) { float d = den[j]; d += __shfl_xor(d, 16); d += __shfl_xor(d, 32); den[j] = d; }
}
__device__ __forceinline__ void dattn_unit(const Args& A, LAS unsigned char* lds, int blk, int head, int tid, int lane, int wave, int flags) {
    unsigned char* ws = A.ws; const int tb = blk * 256; int ss, L; seq_of(tb, ss, L);
    const bf16* Q = (const bf16*)(ws + 5 * SLOT); const bf16* K = (const bf16*)(ws + 6 * SLOT); const bf16* V = (const bf16*)(ws + 7 * SLOT);
    bf16* MIX = (bf16*)(ws + 3 * SLOT); float* ssq = (float*)(ws + OFF_SSQ) + (size_t)T * 7;
    LAS unsigned char* vst = lds + L_VST + wave * VST_BYTES;
    const int kg = lane >> 4, l15 = lane & 15, pos0 = tb - ss;
    const DG g2 = dgeom(2, wave, tb, ss, L), g3 = dgeom(3, wave, tb, ss, L);
    bf16x8 ka[5][4];
    const float mq_ = wave_max(fabsf(A.in[12][lane])), mk_ = wave_max(fabsf(A.in[13][lane]));
    const float c1 = 0.125f * LOG2E, c2 = 8.0f * mq_ * mk_ * LOG2E;
    f32x4 O1[2][4], O2a[1][4], O2b[1][4]; float den1[2], den2a[1], den2b[1];
    DG gp1; gp1.dsh = 0; gp1.r = 0; gp1.mtl = 32 * wave; gp1.m0 = pos0 + 32 * wave; gp1.Lc = L;
    dstage<384>(K, head, ss, L, 0, 0, pos0 - 64, lds, 0, tid); asm volatile("" ::: "memory");
    dstage<384>(V, head, ss, L, 0, 0, pos0 - 64, lds, 384, tid);
    DBAR();
    dfused<2>(Q, head, ss, gp1, 32 * wave, lds, c1, c2, lane, O1, den1);
    DBAR();
    DG gp2; gp2.dsh = 2; gp2.mtl = 16 * (wave & 3); gp2.m0 = (pos0 >> 2) + gp2.mtl; gp2.Lc = L >> 2;
    gp2.r = wave >> 2;
    dstage<192>(K, head, ss, L >> 2, 2, 0, (pos0 >> 2) - 64, lds, 0, tid); asm volatile("" ::: "memory");
    dstage<192>(V, head, ss, L >> 2, 2, 0, (pos0 >> 2) - 64, lds, 384, tid);
    DBAR();
    dfused<1>(Q, head, ss, gp2, 192 * (wave >> 2) + 16 * (wave & 3), lds, c1, c2, lane, O2a, den2a);
    DBAR();
    dstage<192>(K, head, ss, L >> 2, 2, 2, (pos0 >> 2) - 64, lds, 0, tid); asm volatile("" ::: "memory");
    dstage<192>(V, head, ss, L >> 2, 2, 2, (pos0 >> 2) - 64, lds, 384, tid);
    DBAR();
    gp2.r = 2 + (wave >> 2);
    dfused<1>(Q, head, ss, gp2, 192 * (wave >> 2) + 16 * (wave & 3), lds, c1, c2, lane, O2b, den2b);
    DBAR();
#pragma unroll
    for (int j = 0; j < 2; ++j) { const int tl = 32 * wave + 16 * j + l15;
#pragma unroll
        for (int dt = 0; dt < 4; ++dt) *(LAS f32x4*)(lds + L_ACC + tl * ACCSTR + (16 * dt + 4 * kg) * 4) = O1[j][dt];
        if (kg == 0) ((LAS float*)(lds + L_DEN))[tl] = den1[j]; }
    DBAR();
    { const int tl = ((16 * (wave & 3) + l15) << 2) + (wave >> 2);
#pragma unroll
      for (int dt = 0; dt < 4; ++dt) { LAS f32x4* ap = (LAS f32x4*)(lds + L_ACC + tl * ACCSTR + (16 * dt + 4 * kg) * 4); *ap = *ap + O2a[0][dt]; }
      if (kg == 0) { LAS float* dp = (LAS float*)(lds + L_DEN) + tl; *dp = *dp + den2a[0]; }
      const int tl2 = tl + 2;
#pragma unroll
      for (int dt = 0; dt < 4; ++dt) { LAS f32x4* ap = (LAS f32x4*)(lds + L_ACC + tl2 * ACCSTR + (16 * dt + 4 * kg) * 4); *ap = *ap + O2b[0][dt]; }
      if (kg == 0) { LAS float* dp = (LAS float*)(lds + L_DEN) + tl2; *dp = *dp + den2b[0]; } }
    DBAR();
    if (!(flags & 2)) { dtask<false, false>(Q, K, V, head, ss, g2, g3, ka, ka, lds, vst, c1, c2, lane);
    dtask<false, false>(Q, K, V, head, ss, g3, g3, ka, ka, lds, vst, c1, c2, lane); }
    DBAR();
    { const int tl = tid >> 1, d0 = (tid & 1) * 32; const float inv = 1.0f / ((LAS float*)(lds + L_DEN))[tl]; float s = 0.f; float o[32];
#pragma unroll
      for (int i = 0; i < 8; ++i) { const f32x4 a = *(LAS f32x4*)(lds + L_ACC + tl * ACCSTR + (d0 + 4 * i) * 4); o[4 * i] = a[0] * inv; o[4 * i + 1] = a[1] * inv; o[4 * i + 2] = a[2] * inv; o[4 * i + 3] = a[3] * inv; }
#pragma unroll
      for (int i = 0; i < 32; ++i) s += o[i] * o[i];
      s += __shfl_xor(s, 1); if ((tid & 1) == 0) unsafeAtomicAdd(ssq + tb + tl, s);
      bf16* op = MIX + (size_t)(tb + tl) * 1024 + 512 + head * 64 + d0;
#pragma unroll
      for (int i = 0; i < 4; ++i) { v4u w; w.x = pk2(o[8 * i], o[8 * i + 1]); w.y = pk2(o[8 * i + 2], o[8 * i + 3]); w.z = pk2(o[8 * i + 4], o[8 * i + 5]); w.w = pk2(o[8 * i + 6], o[8 * i + 7]); *(v4u*)(op + 8 * i) = w; } }
    DBAR();
}
__device__ __forceinline__ void phase_mixnorm(const Args& A, int tid) {
    bf16* MIX = (bf16*)(A.ws + 3 * SLOT); const float* sa = (const float*)(A.ws + OFF_SSQ) + (size_t)T * 6; const float* sb = sa + T;
    const int c8 = tid & 127, NB = gridDim.x;
    for (int r4 = blockIdx.x; r4 < T / 4; r4 += 4 * NB) {
        v4u q[4]; float rs[4];
#pragma unroll
        for (int i = 0; i < 4; ++i) { int rr = r4 + i * NB; rr = rr < T / 4 ? rr : T / 4 - 1; const int row = rr * 4 + (tid >> 7);
            q[i] = *(const v4u*)(MIX + (size_t)row * 1024 + c8 * 8); rs[i] = (c8 < 64 ? sa[row] : sb[row]); }
#pragma unroll
        for (int i = 0; i < 4; ++i) { int rr = r4 + i * NB; if (rr >= T / 4) continue; const int row = rr * 4 + (tid >> 7);
            const float s = 1.0f / sqrtf(rs[i] * (1.0f / 512.0f) + EPS); float x[8];
            x[0] = bflo(q[i].x) * s; x[1] = bfhi(q[i].x) * s; x[2] = bflo(q[i].y) * s; x[3] = bfhi(q[i].y) * s; x[4] = bflo(q[i].z) * s; x[5] = bfhi(q[i].z) * s; x[6] = bflo(q[i].w) * s; x[7] = bfhi(q[i].w) * s;
            store8(MIX + (size_t)row * 1024 + c8 * 8, x); }
    }
}
__device__ __forceinline__ void xattn_unit(const Args& A, LAS unsigned char* lds, int blk, int head, int tid, int lane, int wave) {
    constexpr int XS2 = 528;
    unsigned char* ws = A.ws; const int tb = blk * 128; const int sq = tb < TP ? (tb >> 13) : 2 + ((tb - TP) >> 12);
    const bf16* QX = (const bf16*)(ws + 5 * SLOT); const bf16* KX = (const bf16*)(ws + OFF_KX) + (size_t)sq * 256 * 1024 + head * 256;
    const bf16* VXT = (const bf16*)(ws + OFF_VXT) + (size_t)head * 256 * NMEM + sq * 256; bf16* XO = (bf16*)(ws + 3 * SLOT);
    const float* ssqq = (const float*)(ws + OFF_SSQ) + (size_t)T * 2;
#pragma unroll 4
    for (int i = 0; i < 16; ++i) { const int idx = tid + 512 * i, row = idx >> 5, ch = idx & 31; *(LAS v4u*)(lds + row * XS2 + ch * 16) = *(const v4u*)(KX + (size_t)row * 1024 + ch * 8); }
    float gm = 0.f;
#pragma unroll
    for (int i = 0; i < 4; ++i) gm = fmaxf(gm, fabsf(A.in[20][lane + 64 * i] * A.in[21][lane + 64 * i]));
    gm = wave_max(gm); const float c2 = 16.0f * gm * LOG2E;
    const int kg = lane >> 4, l15 = lane & 15;
    const int tok = tb + 16 * wave + l15;
    const float c1 = (1.0f / sqrtf(ssqq[(size_t)tok * 4 + head] * (1.0f / 256.0f) + EPS)) * (0.0625f * LOG2E);
    bf16x8 qf[8];
#pragma unroll
    for (int ks = 0; ks < 8; ++ks) qf[ks] = *(const bf16x8*)(QX + (size_t)tok * 1024 + head * 256 + 32 * ks + 8 * kg);
    LDSW(); __syncthreads();
    v4u pw[8]; float den = 0.f;
#pragma unroll
    for (int mt = 0; mt < 16; ++mt) {
        f32x4 st = (f32x4){0.f, 0.f, 0.f, 0.f};
#pragma unroll
        for (int ks = 0; ks < 8; ++ks) { const bf16x8 a = *(const LAS bf16x8*)(lds + (16 * mt + l15) * XS2 + (32 * ks + 8 * kg) * 2); st = MFMA16(a, qf[ks], st); }
        float p[4];
#pragma unroll
        for (int e = 0; e < 4; ++e) { p[e] = __builtin_amdgcn_exp2f(st[e] * c1 - c2); den += p[e]; }
        asm volatile("" ::: "memory");
        if (mt & 1) { pw[mt >> 1].z = pk2(p[0], p[1]); pw[mt >> 1].w = pk2(p[2], p[3]); } else { pw[mt >> 1].x = pk2(p[0], p[1]); pw[mt >> 1].y = pk2(p[2], p[3]); }
    }
    __syncthreads();
#pragma unroll 4
    for (int i = 0; i < 16; ++i) { const int idx = tid + 512 * i, row = idx >> 5, ch = idx & 31; *(LAS v4u*)(lds + row * XS2 + ch * 16) = *(const v4u*)(VXT + (size_t)row * NMEM + ch * 8); }
    den += __shfl_xor(den, 16); den += __shfl_xor(den, 32); const float inv = 1.0f / den;
    LDSW(); __syncthreads();
#pragma unroll 2
    for (int dt = 0; dt < 16; ++dt) {
        f32x4 O = (f32x4){0.f, 0.f, 0.f, 0.f};
#pragma unroll
        for (int c = 0; c < 8; ++c) { const LAS unsigned char* vp = lds + (16 * dt + l15) * XS2 + (32 * c + 4 * kg) * 2; const v2u a = *(const LAS v2u*)vp, b = *(const LAS v2u*)(vp + 32);
            const bf16x8 af = __builtin_bit_cast(bf16x8, ((v4u){a.x, a.y, b.x, b.y})); O = MFMA16(af, __builtin_bit_cast(bf16x8, pw[c]), O); }
        v2u w; w.x = pk2(O[0] * inv, O[1] * inv); w.y = pk2(O[2] * inv, O[3] * inv);
        *(v2u*)(XO + (size_t)tok * 1024 + head * 256 + 16 * dt + 4 * kg) = w;
    }
    __syncthreads();
}
#ifndef MK_ONE_LAUNCH
#define MK_ONE_LAUNCH 1
#endif
constexpr int NPHASE = 13;
__global__ void __launch_bounds__(512, 2) hymba_fwd(Args args) {
    extern __shared__ __attribute__((aligned(16))) unsigned char lds_raw[];
    LAS unsigned char* lds = (LAS unsigned char*)lds_raw;
    const int tid = threadIdx.x, lane = tid & 63, wave = __builtin_amdgcn_readfirstlane(tid >> 6);
    unsigned char* ws = args.ws; const int G = gridDim.x;
    const int lo = args.ph_lo, hi = args.ph_hi;
#define IN(k) (lo <= (k) && (k) < hi)
#define SEAM(k) do { if (IN(k) && IN((k) + 1)) xcd_barrier(bar); } while (0)
    using namespace pg8;
    if (tid < 16) ((LAS unsigned*)(lds + LDS_BYTES - 64))[tid] = 0u;
    __syncthreads();
    XcdBarrier bar = xcd_barrier_post((unsigned*)(ws + OFF_BAR), (volatile LAS unsigned*)(lds + LDS_BYTES - 64));
    float* ssq = (float*)(ws + OFF_SSQ);
    int vcu = (int)blockIdx.x, cxcd = (int)blockIdx.x;
    if (args.pad == 0x5a5a5a5a) cg::this_grid().sync();
    if (IN(0)) { phase_prologue(args, lds, tid, lane, wave); } SEAM(0);
    if (lo == 0 && hi > 1) {
        volatile LAS unsigned* stw = (volatile LAS unsigned*)(lds + LDS_BYTES - 64);
        if (tid == 0) { bool even = (G % 8) == 0; const unsigned per = (unsigned)(G / 8);
            for (unsigned j = 0; j < 16; ++j) { const unsigned cnt = xb_ld(&bar.bar[XB_XCNT(j)]); if (cnt != (j < 8 ? per : 0u)) even = false; }
            const unsigned rank = stw[4];
            if (even && bar.x < 8u && rank < per) { stw[5] = bar.x * per + rank; stw[6] = rank * 8u + bar.x; } else { stw[5] = blockIdx.x; stw[6] = blockIdx.x; } }
        __syncthreads();
        vcu = (int)stw[5]; cxcd = (int)stw[6];
    }
    if (IN(1)) {
        { Gemm g{(const bf16_t*)ws, (const bf16_t*)(ws + OFF_WIN), T, 3328, 1024}; StaticOrder S; S.init(T, 3328, G, cxcd);
          EpiG<1> E{(bf16_t*)(ws + 2 * SLOT), 512, nullptr, nullptr, nullptr, nullptr, nullptr, SLOT / 2, (float*)(ws + OFF_DT), nullptr};
          gemm_phase<EpiG<1>, StaticOrder, true, true>(lds, g, S, E); }
        { Gemm g{(const bf16_t*)(ws + OFF_MEMN), (const bf16_t*)(ws + OFF_WKV), NMEM, 1024, 1024}; StaticOrder S; S.init(NMEM, 1024, G, (cxcd + G - (192 % G)) % G);
          EpiG<0> E{(bf16_t*)(ws + OFF_KX), 1024, nullptr, nullptr, nullptr, nullptr, nullptr, 0, nullptr, nullptr};
          gemm_phase<EpiG<0>, StaticOrder, true, true>(lds, g, S, E); }
    } SEAM(1);
    if (IN(2)) { phase_elementwise(args, tid, lane); } SEAM(2);
    if (IN(3)) {
        for (int u = blockIdx.x; u < 768; u += G) ssd_states_unit(args, lds, u >> 1, u & 1, tid, lane, wave);
        if (!(args.flags & 1)) for (int v = vcu; v < 1536; v += G) dattn_unit(args, lds, v % 192, v / 192, tid, lane, wave, args.flags);
    } SEAM(3);
    if (IN(4)) {
        phase_scan(args, tid);
        { Gemm g{(const bf16_t*)(ws + OFF_WKV) + (size_t)1024 * 1024, (const bf16_t*)(ws + OFF_MEMN), 1024, NMEM, 1024}; StaticOrder S; S.init(1024, NMEM, G, ((int)blockIdx.x + G - (192 % G)) % G);
          EpiG<0> E{(bf16_t*)(ws + OFF_VXT), NMEM, nullptr, nullptr, nullptr, nullptr, nullptr, 0, nullptr, nullptr};
          gemm_phase<EpiG<0>, StaticOrder, true, true>(lds, g, S, E); }
    } SEAM(4);
    if (IN(5)) { for (int u = blockIdx.x; u < 768; u += G) ssd_out_unit(args, lds, u >> 1, u & 1, tid, lane, wave); } SEAM(5);
    if (IN(6)) { phase_mixnorm(args, tid); phase_kxnorm(args, tid); } SEAM(6);
    if (IN(7)) {
        Gemm g{(const bf16_t*)(ws + 3 * SLOT), (const bf16_t*)(ws + OFF_WOUT), T, 1024, 1024}; StaticOrder S; S.init(T, 1024, G, cxcd);
        EpiG<2> E{(bf16_t*)ws, 1024, nullptr, args.in[0], args.in[1], ssq, nullptr, 0, nullptr, nullptr};
        gemm_phase<EpiG<2>, StaticOrder, true, true>(lds, g, S, E);
    } SEAM(7);
    if (IN(8)) {
        Gemm g{(const bf16_t*)ws, (const bf16_t*)(ws + OFF_WQ), T, 1024, 1024}; StaticOrder S; S.init(T, 1024, G, cxcd);
        EpiG<3> E{(bf16_t*)(ws + 5 * SLOT), 1024, nullptr, nullptr, nullptr, ssq + (size_t)T * 2, ssq, 0, nullptr};
        gemm_phase<EpiG<3>, StaticOrder, true, true>(lds, g, S, E);
    } SEAM(8);
    if (IN(9)) { for (int v = vcu; v < 1536; v += G) xattn_unit(args, lds, v % 384, v / 384, tid, lane, wave); } SEAM(9);
    if (IN(10)) {
        Gemm g{(const bf16_t*)(ws + 3 * SLOT), (const bf16_t*)(ws + OFF_WO), T, 1024, 1024}; StaticOrder S; S.init(T, 1024, G, cxcd);
        EpiG<5> E{(bf16_t*)(ws + OFF_HB2), 1024, nullptr, nullptr, nullptr, ssq + T, nullptr, 0, nullptr, (const bf16_t*)ws};
        gemm_phase<EpiG<5>, StaticOrder, true, true>(lds, g, S, E);
    } SEAM(10);
    if (IN(11)) {
        Gemm g{(const bf16_t*)(ws + OFF_HB2), (const bf16_t*)(ws + OFF_W1), T, 4096, 1024}; StaticOrder S; S.init(T, 4096, G, cxcd);
        EpiG<6> E{(bf16_t*)ws, 4096, nullptr, nullptr, nullptr, nullptr, ssq + T, 0, nullptr};
        gemm_phase<EpiG<6>, StaticOrder, true, true>(lds, g, S, E);
    } SEAM(11);
    if (IN(12)) {
        Gemm g{(const bf16_t*)ws, (const bf16_t*)(ws + OFF_W2), T, 1024, 4096}; StaticOrder S; S.init(T, 1024, G, cxcd);
        EpiG<7> E{nullptr, 0, args.out, nullptr, nullptr, nullptr, nullptr, 0, nullptr, (const bf16_t*)(ws + OFF_HB2)};
        gemm_phase<EpiG<7>, StaticOrder, true, true>(lds, g, S, E);
    }
#undef IN
#undef SEAM
}

extern "C" void kernel_launch(void* const* d_in, const int* in_sizes, int n_in, void* d_out, int out_size, void* d_ws, size_t ws_size, hipStream_t stream) {
    static int grid = 0;
    if (grid == 0) {
        if (n_in != 26 || out_size != T * 1024 || ws_size < WS_NEED) { fprintf(stderr, "kernel_launch: unexpected shapes (n_in %d out %d ws %zu)\n", n_in, out_size, ws_size); grid = -1; return; }
        int dev = 0, cus = 0, per_cu = 0;
        (void)hipGetDevice(&dev); (void)hipDeviceGetAttribute(&cus, hipDeviceAttributeMultiprocessorCount, dev);
        if (hipFuncSetAttribute((const void*)hymba_fwd, hipFuncAttributeMaxDynamicSharedMemorySize, LDS_BYTES) != hipSuccess) { fprintf(stderr, "kernel_launch: hipFuncSetAttribute failed\n"); grid = -1; return; }
        (void)hipOccupancyMaxActiveBlocksPerMultiprocessor(&per_cu, (const void*)hymba_fwd, 512, LDS_BYTES);
        if (per_cu < 1) per_cu = 1;
        grid = cus * per_cu; (void)hipGetLastError();
    }
    if (grid < 0) return;
    (void)hipMemsetAsync((char*)d_ws + OFF_BAR, 0, 16384, stream);
    Args a{};
    for (int i = 0; i < 26; ++i) a.in[i] = (const float*)d_in[i];
    a.out = (float*)d_out; a.ws = (unsigned char*)d_ws;
#if MK_ONE_LAUNCH
    void* kargs[] = {&a};
#ifdef PROBE_K
    a.ph_lo = 0; a.ph_hi = PROBE_K + 1; a.flags = PROBE_FLAGS;
    (void)hipLaunchCooperativeKernel((const void*)hymba_fwd, dim3(grid), dim3(512), kargs, LDS_BYTES, stream);
    (void)hipMemsetAsync((char*)d_ws + OFF_BAR, 0, 16384, stream);
#endif
    a.ph_lo = 0; a.ph_hi = NPHASE; a.flags = 0;
    hipError_t e = hipLaunchCooperativeKernel((const void*)hymba_fwd, dim3(grid), dim3(512), kargs, LDS_BYTES, stream);
    if (e != hipSuccess) fprintf(stderr, "cooperative launch failed: %s (grid %d)\n", hipGetErrorString(e), grid);
#else
    for (int p = 0; p < NPHASE; ++p) { a.ph_lo = p; a.ph_hi = p + 1; hipLaunchKernelGGL(hymba_fwd, dim3(grid), dim3(512), LDS_BYTES, stream, a); }
#endif
}
```

```cpp
#include <hip/hip_runtime.h>
#include <hip/hip_cooperative_groups.h>
#include <cstdio>
#include <cstdint>
namespace cg = cooperative_groups;
namespace pg8 {
#define PG8_LAS __attribute__((address_space(3)))
typedef unsigned short bf16_t;
typedef short bf16x8 __attribute__((ext_vector_type(8)));
typedef float f32x4 __attribute__((ext_vector_type(4)));
typedef unsigned u32x4 __attribute__((ext_vector_type(4)));
constexpr int BM = 256, BK = 64, HALF = 128, HTB = HALF * BK * 2  , STAGE_BYTES = 8 * HTB, NXCD = 8, WGM = 8;

__host__ __device__ __forceinline__ int lds_byte(int r, int c) { const int st = (r >> 4) * 2 + (c >> 5), rr = r & 15, cc = c & 31, ob = rr * 64 + cc * 2; return st * 1024 + (ob ^ (((ob >> 9) & 1) << 5)); }
__host__ __device__ __forceinline__ void stage_rc(int b, int& R, int& C) { const int st = b / 1024, sb = b % 1024, swz = sb ^ (((sb >> 9) & 1) << 5); R = (st >> 1) * 16 + swz / 64; C = (st & 1) * 32 + (swz % 64) / 2; }
__host__ __device__ __forceinline__ int perm32(int rho) { const int n = rho >> 4, i = rho & 15; return 8 * (i >> 2) + 4 * n + (i & 3); }

struct Unit { int pm, pn; };
struct Gemm { const bf16_t* A; const bf16_t* Bt; int M, N, K; };

struct StaticOrder {
    int nM, nN, nwg, G, c;
    __host__ __device__ void init(int M, int N, int G_, int c_) { nM = M / BM; nN = N / BM; nwg = nM * nN; G = G_; c = c_; }
    __host__ __device__ bool next(int i, Unit& u) const {
        const long L = (long)i * G + c; if (L >= nwg) return false;
        int wgid = (int)L; { const int q = nwg / NXCD, r = nwg % NXCD, xcd = wgid % NXCD, off = wgid / NXCD; wgid = (xcd < r ? xcd * (q + 1) : r * (q + 1) + (xcd - r) * q) + off; }
        const int nig = WGM * nN, gid = wgid / nig, fm = gid * WGM, gsz = (nM - fm) < WGM ? (nM - fm) : WGM;
        u.pm = fm + ((wgid % nig) % gsz); u.pn = (wgid % nig) / gsz; return true;
    }
    __device__ __forceinline__ void a_ready(const Unit&) const {}
    __device__ __forceinline__ void done(const Unit&) const {}
};

__device__ __forceinline__ unsigned cvt_pk_bf16(float lo, float hi) { unsigned r; asm volatile("v_cvt_pk_bf16_f32 %0, %1, %2" : "=v"(r) : "v"(lo), "v"(hi)); return r; }
typedef float f32x2 __attribute__((ext_vector_type(2)));
template <class Epi, class Sched, bool ALIGN_EPI = false, bool SP2 = false>
__device__ __forceinline__ void gemm_phase(PG8_LAS unsigned char* lds, const Gemm g, const Sched& S, const Epi& E) {
    const int tid = threadIdx.x, wid = __builtin_amdgcn_readfirstlane(tid >> 6), lane = tid & 63, wr = wid >> 2, wc = wid & 3, fr = lane & 15, fq = lane >> 4;
    const int K = g.K, nt = K / BK;
    unsigned voffA[2], voffB[2];
#pragma unroll
    for (int i = 0; i < 2; ++i) { int R, C; stage_rc(tid * 16 + i * 8192, R, C); const int Rb = Epi::PERM ? ((R & ~31) + perm32(R & 31)) : R;
        voffA[i] = (unsigned)(R * K + C) * 2u; voffB[i] = (unsigned)(Rb * K + C) * 2u; }
    const size_t kstep = (size_t)(BK * 2);
    const size_t hstep = (size_t)HALF * K * 2;
    const size_t tstep = 2 * hstep;
    const unsigned ldsw = (unsigned)wid * 1024u;
    const int aoff = lds_byte(wr * 64 + fr, fq * 8), boff = lds_byte(wc * 32 + fr, fq * 8);
#define PG8_SA(b, h) (((b) * 2 + (h)) * HTB)
#define PG8_SB(b, h) ((4 + (b) * 2 + (h)) * HTB)
#define PG8_STAGE(bufoff, gbase, voff) do { _Pragma("unroll") for (int _i = 0; _i < 2; ++_i) \
        __builtin_amdgcn_global_load_lds((const unsigned*)((const char*)(gbase) + (voff)[_i]), (PG8_LAS unsigned*)(lds + (bufoff) + ldsw + _i * 8192), 16, 0, 0); } while (0)
#define PG8_LDA(dst, b, h) do { _Pragma("unroll") for (int m = 0; m < 4; ++m) _Pragma("unroll") for (int k = 0; k < 2; ++k) dst[m][k] = *(const PG8_LAS bf16x8*)(lds + PG8_SA(b, h) + aoff + m * 2048 + k * 1024); } while (0)
#define PG8_LDB(dst, b, h) do { _Pragma("unroll") for (int n = 0; n < 2; ++n) _Pragma("unroll") for (int k = 0; k < 2; ++k) dst[n][k] = *(const PG8_LAS bf16x8*)(lds + PG8_SB(b, h) + boff + n * 2048 + k * 1024); } while (0)
#define PG8_MMA(ai, bj, At, Bt) do { __builtin_amdgcn_s_setprio(1); _Pragma("unroll") for (int m = 0; m < 4; ++m) _Pragma("unroll") for (int n = 0; n < 2; ++n) _Pragma("unroll") for (int k = 0; k < 2; ++k) \
        acc[ai][bj][m][n] = __builtin_amdgcn_mfma_f32_16x16x32_bf16(Bt[n][k], At[m][k], acc[ai][bj][m][n], 0, 0, 0); __builtin_amdgcn_s_setprio(0); } while (0)
#define PG8_WAIT_V(n) asm volatile("s_waitcnt vmcnt(" #n ")" ::: "memory")
#define PG8_WAIT_L(n) asm volatile("s_waitcnt lgkmcnt(" #n ")" ::: "memory")
#define PG8_BAR __builtin_amdgcn_s_barrier()
#define PG8_SCHED __builtin_amdgcn_sched_barrier(0)
    Unit cur, nxt; int ui = 0;
    if (!S.next(0, cur)) return;
    f32x4 acc[2][2][4][2];
#pragma unroll
    for (int a = 0; a < 2; ++a)
#pragma unroll
        for (int b = 0; b < 2; ++b)
#pragma unroll
            for (int m = 0; m < 4; ++m)
#pragma unroll
                for (int n = 0; n < 2; ++n) acc[a][b][m][n] = (f32x4){0.f, 0.f, 0.f, 0.f};
    bf16x8 At[4][2], B0[2][2], B1[2][2];
    const char* cA = (const char*)g.A + (size_t)cur.pm * tstep; const char* cB = (const char*)g.Bt + (size_t)cur.pn * tstep;
    S.a_ready(cur);
    if constexpr (SP2) {
        PG8_STAGE(PG8_SB(0, 0), cB, voffB); PG8_STAGE(PG8_SB(0, 1), cB + hstep, voffB); PG8_STAGE(PG8_SA(0, 0), cA, voffA); PG8_STAGE(PG8_SA(0, 1), cA + hstep, voffA);
        if (wr == 1) PG8_BAR;
        PG8_WAIT_V(2); PG8_BAR;
        PG8_STAGE(PG8_SB(1, 0), cB + kstep, voffB); PG8_STAGE(PG8_SA(1, 0), cA + kstep, voffA); PG8_STAGE(PG8_SB(1, 1), cB + hstep + kstep, voffB);
        PG8_WAIT_V(6); PG8_BAR;
    } else {
        PG8_STAGE(PG8_SB(0, 0), cB, voffB); PG8_STAGE(PG8_SA(0, 0), cA, voffA); PG8_STAGE(PG8_SB(0, 1), cB + hstep, voffB); PG8_STAGE(PG8_SA(0, 1), cA + hstep, voffA);
        if (wr == 1) PG8_BAR;
        PG8_WAIT_V(4); PG8_BAR;
        PG8_STAGE(PG8_SB(1, 0), cB + kstep, voffB); PG8_STAGE(PG8_SA(1, 0), cA + kstep, voffA); PG8_STAGE(PG8_SB(1, 1), cB + hstep + kstep, voffB);
        PG8_WAIT_V(6); PG8_BAR;
    }
    for (;;) {
        const bool has_next = S.next(ui + 1, nxt);
        const char* nA = has_next ? (const char*)g.A + (size_t)nxt.pm * tstep : cA; const char* nB = has_next ? (const char*)g.Bt + (size_t)nxt.pn * tstep : cB;
        for (int t = 0; t < nt; t += 2) {
            const bool last = (t == nt - 2);
            const char* a1 = cA + (size_t)(t + 1) * kstep;
            const char* a2 = last ? nA : cA + (size_t)(t + 2) * kstep; const char* b2 = last ? nB : cB + (size_t)(t + 2) * kstep;
            const char* a3 = a2 + kstep; const char* b3 = b2 + kstep;
            if (last && has_next) S.a_ready(nxt);
            if constexpr (SP2) {
            PG8_LDB(B0, 0, 0); PG8_LDB(B1, 0, 1); PG8_SCHED; PG8_LDA(At, 0, 0); PG8_STAGE(PG8_SA(1, 1), a1 + hstep, voffA);
            PG8_WAIT_V(8); PG8_WAIT_L(0); PG8_BAR; PG8_MMA(0, 0, At, B0); PG8_MMA(0, 1, At, B1); PG8_BAR; PG8_SCHED;
            PG8_LDA(At, 0, 1); PG8_STAGE(PG8_SB(0, 0), b2, voffB); PG8_STAGE(PG8_SB(0, 1), b2 + hstep, voffB); PG8_STAGE(PG8_SA(0, 0), a2, voffA);
            PG8_WAIT_V(8); PG8_WAIT_L(0); PG8_BAR; PG8_MMA(1, 0, At, B0); PG8_MMA(1, 1, At, B1); PG8_BAR; PG8_SCHED;
            PG8_LDB(B0, 1, 0); PG8_LDB(B1, 1, 1); PG8_SCHED; PG8_LDA(At, 1, 0); PG8_STAGE(PG8_SA(0, 1), a2 + hstep, voffA);
            PG8_WAIT_V(8); PG8_WAIT_L(0); PG8_BAR; PG8_MMA(0, 0, At, B0); PG8_MMA(0, 1, At, B1); PG8_BAR; PG8_SCHED;
            PG8_LDA(At, 1, 1); PG8_STAGE(PG8_SB(1, 0), b3, voffB); PG8_STAGE(PG8_SB(1, 1), b3 + hstep, voffB); PG8_STAGE(PG8_SA(1, 0), a3, voffA);
            PG8_WAIT_V(8); PG8_WAIT_L(0); PG8_BAR; PG8_MMA(1, 0, At, B0); PG8_MMA(1, 1, At, B1); PG8_BAR; PG8_SCHED;
            } else {
            PG8_LDB(B0, 0, 0); PG8_SCHED; PG8_LDA(At, 0, 0); PG8_STAGE(PG8_SA(1, 1), a1 + hstep, voffA);
            PG8_WAIT_L(8); PG8_BAR; PG8_WAIT_L(0); PG8_MMA(0, 0, At, B0); PG8_BAR; PG8_SCHED;
            PG8_LDB(B1, 0, 1); PG8_STAGE(PG8_SB(0, 0), b2, voffB);
            PG8_BAR; PG8_WAIT_L(0); PG8_MMA(0, 1, At, B1); PG8_BAR;
            PG8_LDA(At, 0, 1); PG8_STAGE(PG8_SA(0, 0), a2, voffA);
            PG8_BAR; PG8_WAIT_L(0); PG8_MMA(1, 0, At, B0); PG8_BAR; PG8_SCHED;
            PG8_STAGE(PG8_SB(0, 1), b2 + hstep, voffB);
            PG8_WAIT_V(6); PG8_BAR; PG8_MMA(1, 1, At, B1); PG8_BAR;
            PG8_LDB(B0, 1, 0); PG8_SCHED; PG8_LDA(At, 1, 0); PG8_STAGE(PG8_SA(0, 1), a2 + hstep, voffA);
            PG8_WAIT_L(8); PG8_BAR; PG8_WAIT_L(0); PG8_MMA(0, 0, At, B0); PG8_BAR; PG8_SCHED;
            PG8_LDB(B1, 1, 1); PG8_STAGE(PG8_SB(1, 0), b3, voffB);
            PG8_BAR; PG8_WAIT_L(0); PG8_MMA(0, 1, At, B1); PG8_BAR;
            PG8_LDA(At, 1, 1); PG8_STAGE(PG8_SA(1, 0), a3, voffA);
            PG8_BAR; PG8_WAIT_L(0); PG8_MMA(1, 0, At, B0); PG8_BAR; PG8_SCHED;
            PG8_STAGE(PG8_SB(1, 1), b3 + hstep, voffB);
            PG8_WAIT_V(6); PG8_BAR; PG8_MMA(1, 1, At, B1); PG8_BAR;
            }
        }
        if constexpr (ALIGN_EPI) { if (wr == 0) PG8_BAR; }
        if constexpr (!Epi::AFTER_DRAIN) { E(acc, cur, wr, wc, fr, fq); S.done(cur); }
        if (!has_next) break;
#pragma unroll
        for (int a = 0; a < 2; ++a)
#pragma unroll
            for (int b = 0; b < 2; ++b)
#pragma unroll
                for (int m = 0; m < 4; ++m)
#pragma unroll
                    for (int n = 0; n < 2; ++n) acc[a][b][m][n] = (f32x4){0.f, 0.f, 0.f, 0.f};
        cur = nxt; cA = nA; cB = nB; ++ui;
        if constexpr (ALIGN_EPI) { if (wr == 1) PG8_BAR; }
    }
    PG8_WAIT_V(0);
    if constexpr (!ALIGN_EPI) { if (wr == 0) PG8_BAR; }
    PG8_BAR;
    if constexpr (Epi::AFTER_DRAIN) { E.fused(acc, cur, wr, wc, fr, fq, lds, wid, lane); S.done(cur); }
#undef PG8_SA
#undef PG8_SB
#undef PG8_STAGE
#undef PG8_LDA
#undef PG8_LDB
#undef PG8_MMA
#undef PG8_WAIT_V
#undef PG8_WAIT_L
#undef PG8_BAR
#undef PG8_SCHED
}
}
namespace pg8 {
constexpr int TPROMPT = 16384;
template <int MODE> struct EpiG {
    static constexpr bool PERM = true, AFTER_DRAIN = false;
    bf16_t* ob; int ldb; float* of; const float* r0; const float* r1; float* ssq; const float* rin; size_t split_stride; float* dt; const bf16_t* rb;
    __device__ __forceinline__ void operator()(const f32x4 (&acc)[2][2][4][2], const Unit& u, int wr, int wc, int fr, int fq) const {
        const int row0 = u.pm * BM + wr * 64 + fr; const int colt = u.pn * BM; const int cl = wc * 32 + 8 * fq;
        if (MODE == 2 || MODE == 5 || MODE == 7) {
            f32x4 ra[8][2][2]; u32x4 rv[8][2];
            constexpr int AHEAD = (MODE == 2) ? 1 : 2;
#define EPI_LDRES(g_) do { const int nrow_ = row0 + ((g_) >> 2) * HALF + ((g_) & 3) * 16; \
                if (MODE == 2) { const float* rp_ = (nrow_ < TPROMPT ? r0 + (size_t)nrow_ * 1024 : r1 + (size_t)(nrow_ - TPROMPT) * 1024) + colt + cl; \
                    _Pragma("unroll") for (int bj = 0; bj < 2; ++bj) { ra[g_][bj][0] = *(const f32x4*)(rp_ + bj * HALF); ra[g_][bj][1] = *(const f32x4*)(rp_ + bj * HALF + 4); } } \
                else { const bf16_t* rp_ = rb + (size_t)nrow_ * 1024 + colt + cl; \
                    _Pragma("unroll") for (int bj = 0; bj < 2; ++bj) rv[g_][bj] = *(const u32x4*)(rp_ + bj * HALF); } } while (0)
#pragma unroll
            for (int g = 0; g < AHEAD; ++g) EPI_LDRES(g);
#pragma unroll
            for (int g = 0; g < 8; ++g) {
                const int ai = g >> 2, m = g & 3; const int row = row0 + ai * HALF + m * 16;
                if (g + AHEAD < 8) EPI_LDRES(g + AHEAD);
                float s = 0.f;
#pragma unroll
                for (int bj = 0; bj < 2; ++bj) {
                    f32x4 v0 = acc[ai][bj][m][0], v1 = acc[ai][bj][m][1];
                    if (MODE == 2) { v0 += ra[g][bj][0]; v1 += ra[g][bj][1]; }
                    else { const u32x4 rr = rv[g][bj];
                        v0[0] += __uint_as_float(rr.x << 16); v0[1] += __uint_as_float(rr.x & 0xffff0000u); v0[2] += __uint_as_float(rr.y << 16); v0[3] += __uint_as_float(rr.y & 0xffff0000u);
                        v1[0] += __uint_as_float(rr.z << 16); v1[1] += __uint_as_float(rr.z & 0xffff0000u); v1[2] += __uint_as_float(rr.w << 16); v1[3] += __uint_as_float(rr.w & 0xffff0000u); }
                    if (MODE == 7) { float* op = of + (size_t)row * 1024 + colt + cl + bj * HALF; *(f32x4*)op = v0; *(f32x4*)(op + 4) = v1; }
                    else { u32x4 w; w.x = cvt_pk_bf16(v0[0], v0[1]); w.y = cvt_pk_bf16(v0[2], v0[3]); w.z = cvt_pk_bf16(v1[0], v1[1]); w.w = cvt_pk_bf16(v1[2], v1[3]);
                        *(u32x4*)(ob + (size_t)row * 1024 + colt + cl + bj * HALF) = w;
                        s += (v0[0] * v0[0] + v0[1] * v0[1]) + (v0[2] * v0[2] + v0[3] * v0[3]) + (v1[0] * v1[0] + v1[1] * v1[1]) + (v1[2] * v1[2] + v1[3] * v1[3]); }
                }
                if (MODE != 7) { s += __shfl_xor(s, 16); s += __shfl_xor(s, 32); if (fq == 0) unsafeAtomicAdd(ssq + row, s); }
            }
#undef EPI_LDRES
            return;
        }
        float rsv[2][4];
        if (MODE == 3 || MODE == 6) {
#pragma unroll
            for (int ai = 0; ai < 2; ++ai)
#pragma unroll
                for (int m = 0; m < 4; ++m) rsv[ai][m] = rin[row0 + ai * HALF + m * 16];
#pragma unroll
            for (int ai = 0; ai < 2; ++ai)
#pragma unroll
                for (int m = 0; m < 4; ++m) rsv[ai][m] = 1.0f / sqrtf(rsv[ai][m] * (1.0f / 1024.0f) + 1e-6f);
        }
#pragma unroll
        for (int ai = 0; ai < 2; ++ai)
#pragma unroll
            for (int m = 0; m < 4; ++m) {
                const int row = row0 + ai * HALF + m * 16;
                if (MODE == 0) {
#pragma unroll
                    for (int bj = 0; bj < 2; ++bj) { const f32x4 v0 = acc[ai][bj][m][0], v1 = acc[ai][bj][m][1]; u32x4 w; w.x = cvt_pk_bf16(v0[0], v0[1]); w.y = cvt_pk_bf16(v0[2], v0[3]); w.z = cvt_pk_bf16(v1[0], v1[1]); w.w = cvt_pk_bf16(v1[2], v1[3]);
                        *(u32x4*)(ob + (size_t)row * ldb + colt + cl + bj * HALF) = w; }
                } else if (MODE == 1) {
                    if (u.pn < 12) { bf16_t* base = ob + (size_t)(u.pn >> 1) * split_stride + (size_t)row * 512 + (u.pn & 1) * 256 + cl;
#pragma unroll
                        for (int bj = 0; bj < 2; ++bj) { const f32x4 v0 = acc[ai][bj][m][0], v1 = acc[ai][bj][m][1]; u32x4 w; w.x = cvt_pk_bf16(v0[0], v0[1]); w.y = cvt_pk_bf16(v0[2], v0[3]); w.z = cvt_pk_bf16(v1[0], v1[1]); w.w = cvt_pk_bf16(v1[2], v1[3]);
                            *(u32x4*)(base + bj * HALF) = w; }
                    } else if (wc == 0 && fq < 2) { float* p = dt + (size_t)row * 16 + 8 * fq; *(f32x4*)p = acc[ai][0][m][0]; *(f32x4*)(p + 4) = acc[ai][0][m][1]; }
                } else if (MODE == 2) {
                    const float* rp = (row < TPROMPT ? r0 + (size_t)row * 1024 : r1 + (size_t)(row - TPROMPT) * 1024) + colt + cl; float s = 0.f;
#pragma unroll
                    for (int bj = 0; bj < 2; ++bj) { const f32x4 v0 = acc[ai][bj][m][0] + *(const f32x4*)(rp + bj * HALF), v1 = acc[ai][bj][m][1] + *(const f32x4*)(rp + bj * HALF + 4);
                        u32x4 w; w.x = cvt_pk_bf16(v0[0], v0[1]); w.y = cvt_pk_bf16(v0[2], v0[3]); w.z = cvt_pk_bf16(v1[0], v1[1]); w.w = cvt_pk_bf16(v1[2], v1[3]);
                        *(u32x4*)(ob + (size_t)row * 1024 + colt + cl + bj * HALF) = w;
                        s += (v0[0] * v0[0] + v0[1] * v0[1]) + (v0[2] * v0[2] + v0[3] * v0[3]) + (v1[0] * v1[0] + v1[1] * v1[1]) + (v1[2] * v1[2] + v1[3] * v1[3]); }
                    s += __shfl_xor(s, 16); s += __shfl_xor(s, 32); if (fq == 0) unsafeAtomicAdd(ssq + row, s);
                } else if (MODE == 5 || MODE == 7) {
                    const bf16_t* rp = rb + (size_t)row * 1024 + colt + cl; float s = 0.f;
#pragma unroll
                    for (int bj = 0; bj < 2; ++bj) { const u32x4 rr = *(const u32x4*)(rp + bj * HALF);
                        f32x4 v0 = acc[ai][bj][m][0], v1 = acc[ai][bj][m][1];
                        v0[0] += __uint_as_float(rr.x << 16); v0[1] += __uint_as_float(rr.x & 0xffff0000u); v0[2] += __uint_as_float(rr.y << 16); v0[3] += __uint_as_float(rr.y & 0xffff0000u);
                        v1[0] += __uint_as_float(rr.z << 16); v1[1] += __uint_as_float(rr.z & 0xffff0000u); v1[2] += __uint_as_float(rr.w << 16); v1[3] += __uint_as_float(rr.w & 0xffff0000u);
                        if (MODE == 5) { u32x4 w; w.x = cvt_pk_bf16(v0[0], v0[1]); w.y = cvt_pk_bf16(v0[2], v0[3]); w.z = cvt_pk_bf16(v1[0], v1[1]); w.w = cvt_pk_bf16(v1[2], v1[3]);
                            *(u32x4*)(ob + (size_t)row * 1024 + colt + cl + bj * HALF) = w;
                            s += (v0[0] * v0[0] + v0[1] * v0[1]) + (v0[2] * v0[2] + v0[3] * v0[3]) + (v1[0] * v1[0] + v1[1] * v1[1]) + (v1[2] * v1[2] + v1[3] * v1[3]); }
                        else { float* op = of + (size_t)row * 1024 + colt + cl + bj * HALF; *(f32x4*)op = v0; *(f32x4*)(op + 4) = v1; } }
                    if (MODE == 5) { s += __shfl_xor(s, 16); s += __shfl_xor(s, 32); if (fq == 0) unsafeAtomicAdd(ssq + row, s); }
                } else if (MODE == 3 || MODE == 6) {
                    const float rs = rsv[ai][m]; float s = 0.f;
#pragma unroll
                    for (int bj = 0; bj < 2; ++bj) { f32x4 v0 = acc[ai][bj][m][0] * rs, v1 = acc[ai][bj][m][1] * rs;
                        if (MODE == 6) {
#pragma unroll
                            for (int e = 0; e < 4; ++e) { const float a = fmaxf(v0[e], 0.f), b = fmaxf(v1[e], 0.f); v0[e] = a * a; v1[e] = b * b; } }
                        u32x4 w; w.x = cvt_pk_bf16(v0[0], v0[1]); w.y = cvt_pk_bf16(v0[2], v0[3]); w.z = cvt_pk_bf16(v1[0], v1[1]); w.w = cvt_pk_bf16(v1[2], v1[3]);
                        *(u32x4*)(ob + (size_t)row * ldb + colt + cl + bj * HALF) = w;
                        if (MODE == 3) s += (v0[0] * v0[0] + v0[1] * v0[1]) + (v0[2] * v0[2] + v0[3] * v0[3]) + (v1[0] * v1[0] + v1[1] * v1[1]) + (v1[2] * v1[2] + v1[3] * v1[3]); }
                    if (MODE == 3) { s += __shfl_xor(s, 16); s += __shfl_xor(s, 32); if (fq == 0) unsafeAtomicAdd(ssq + (size_t)row * 4 + u.pn, s); }
                }
            }
    }
};
}
#define LAS __attribute__((address_space(3)))
typedef unsigned short bf16;
typedef unsigned v4u __attribute__((ext_vector_type(4)));
typedef unsigned v2u __attribute__((ext_vector_type(2)));
typedef float f32x4 __attribute__((ext_vector_type(4)));
typedef short bf16x8 __attribute__((ext_vector_type(8)));
typedef short v4i16_t __attribute__((ext_vector_type(4)));

constexpr int T = 49152, TP = 16384, DM = 1024, NMEM = 2560;
constexpr size_t MiB = 1u << 20;
constexpr size_t SLOT = (size_t)T * 512 * 2;
constexpr size_t OFF_WIN = 384 * MiB, OFF_MEMN = 392 * MiB, OFF_KX = 400 * MiB, OFF_VXT = 408 * MiB, OFF_DT = 416 * MiB, OFF_DEC = 420 * MiB;
constexpr size_t OFF_HB2 = 384 * MiB;
constexpr size_t OFF_W1 = 480 * MiB, OFF_W2 = 488 * MiB, OFF_WOUT = 496 * MiB, OFF_WQ = 498 * MiB, OFF_WKV = 500 * MiB, OFF_WO = 504 * MiB, OFF_SSQ = 506 * MiB;
constexpr size_t OFF_BAR = 509 * MiB;
constexpr size_t WS_NEED = 512 * MiB;
constexpr int LDS_BYTES = 147456;
constexpr float EPS = 1e-6f;
constexpr float LOG2E = 1.4426950408889634f;

struct Args { const float* in[26]; float* out; unsigned char* ws; int ph_lo, ph_hi, flags, pad; };

typedef float f32x2_t __attribute__((ext_vector_type(2))); typedef __bf16 bf16x2_t __attribute__((ext_vector_type(2)));
__device__ __forceinline__ unsigned pk2(float lo, float hi) { const f32x2_t v = {lo, hi}; const bf16x2_t b = __builtin_convertvector(v, bf16x2_t); return __builtin_bit_cast(unsigned, b); }
__device__ __forceinline__ unsigned f2bf(float f) { return pk2(f, 0.f) & 0xffffu; }
__device__ __forceinline__ float bflo(unsigned u) { return __uint_as_float(u << 16); }
__device__ __forceinline__ float bfhi(unsigned u) { return __uint_as_float(u & 0xffff0000u); }
__device__ __forceinline__ float bf1(bf16 b) { return __uint_as_float((unsigned)b << 16); }
__device__ __forceinline__ float wave_sum(float v) {
#pragma unroll
    for (int o = 1; o < 64; o <<= 1) v += __shfl_xor(v, o);
    return v; }
__device__ __forceinline__ float wave_max(float v) {
#pragma unroll
    for (int o = 1; o < 64; o <<= 1) v = fmaxf(v, __shfl_xor(v, o));
    return v; }
__device__ __forceinline__ void seq_of(int t, int& start, int& len) { if (t < TP) { start = t & ~8191; len = 8192; } else { start = TP + ((t - TP) & ~4095); len = 4096; } }
#define LDSW() asm volatile("s_waitcnt lgkmcnt(0)" ::: "memory")
#define MFMA16(a, b, c) __builtin_amdgcn_mfma_f32_16x16x32_bf16((a), (b), (c), 0, 0, 0)
__device__ __forceinline__ bf16x8 tr_frag(LAS unsigned char* img, int stride, int rowA, int rowB, int col0, int lane) {
    const int q = (lane & 15) >> 2, pp = lane & 3;
    const v4i16_t a = __builtin_amdgcn_ds_read_tr16_b64_v4i16((LAS v4i16_t*)(img + (rowA + q) * stride + (col0 + 4 * pp) * 2));
    const v4i16_t b = __builtin_amdgcn_ds_read_tr16_b64_v4i16((LAS v4i16_t*)(img + (rowB + q) * stride + (col0 + 4 * pp) * 2));
    return (bf16x8){a[0], a[1], a[2], a[3], b[0], b[1], b[2], b[3]};
}
__device__ __forceinline__ bf16x8 pack8(const f32x4& a, const f32x4& b) { v4u w; w.x = pk2(a[0], a[1]); w.y = pk2(a[2], a[3]); w.z = pk2(b[0], b[1]); w.w = pk2(b[2], b[3]); return __builtin_bit_cast(bf16x8, w); }

__device__ __forceinline__ void p0_transpose_item(const float* W, int ldw, int K, int ncols, bf16* WT, int row_off, const float* g0, const float* g1, LAS float* scr, int item, int lane) {
    const int nblk = ncols / 32, kb = item / nblk, nb = item % nblk, k0 = 64 * kb, n0 = 32 * nb;
#pragma unroll
    for (int i = 0; i < 8; ++i) { const int kk = 8 * i + (lane >> 3), nq = (lane & 7) * 4; const int k = k0 + kk; const float gg = g0 ? (k < 512 ? g0[k] : g1[k - 512]) : 1.0f;
        const f32x4 v = *(const f32x4*)(W + (size_t)k * ldw + n0 + nq);
        scr[kk * 33 + nq] = v[0] * gg; scr[kk * 33 + nq + 1] = v[1] * gg; scr[kk * 33 + nq + 2] = v[2] * gg; scr[kk * 33 + nq + 3] = v[3] * gg; }
    LDSW();
    const int c = lane & 7;
#pragma unroll
    for (int j = 0; j < 4; ++j) { const int n = (lane >> 3) + 8 * j; const LAS float* s = scr + (8 * c) * 33 + n;
        v4u o; o.x = pk2(s[0 * 33], s[1 * 33]); o.y = pk2(s[2 * 33], s[3 * 33]); o.z = pk2(s[4 * 33], s[5 * 33]); o.w = pk2(s[6 * 33], s[7 * 33]);
        *(v4u*)(WT + (size_t)(row_off + n0 + n) * K + k0 + 8 * c) = o; }
    LDSW();
}
template <int NR> __device__ __forceinline__ void rms_rows_to_bf16(const float* const (&xrow)[NR], const f32x4 (&g)[4], bf16* const (&orow)[NR], int lane) {
    f32x4 v[NR][4];
#pragma unroll
    for (int r = 0; r < NR; ++r)
#pragma unroll
        for (int j = 0; j < 4; ++j) v[r][j] = ((const f32x4*)xrow[r])[lane + 64 * j];
#pragma unroll
    for (int r = 0; r < NR; ++r) { float s = 0.f;
#pragma unroll
        for (int j = 0; j < 4; ++j) s += (v[r][j].x * v[r][j].x + v[r][j].y * v[r][j].y) + (v[r][j].z * v[r][j].z + v[r][j].w * v[r][j].w);
        const float rs = 1.0f / sqrtf(wave_sum(s) * (1.0f / 1024.0f) + EPS);
        unsigned long long* o8 = (unsigned long long*)orow[r] + lane;
#pragma unroll
        for (int j = 0; j < 4; ++j) o8[64 * j] = (unsigned long long)pk2(v[r][j].x * rs * g[j].x, v[r][j].y * rs * g[j].y) | ((unsigned long long)pk2(v[r][j].z * rs * g[j].z, v[r][j].w * rs * g[j].w) << 32); }
}
__device__ __forceinline__ void phase_prologue(const Args& A, LAS unsigned char* lds, int tid, int lane, int wave) {
    unsigned char* ws = A.ws;
    LAS float* scr = (LAS float*)(lds + wave * 16384);
    const int G = gridDim.x, gw = blockIdx.x * 8 + wave, NGW = G * 8;
    bf16* Win_t = (bf16*)(ws + OFF_WIN);
    for (int it = gw; it < 8192; it += NGW) {
        int r = it;
        if (r < 768) { p0_transpose_item(A.in[5], 3088, 1024, 1536, Win_t, 0, nullptr, nullptr, scr, r, lane); continue; } r -= 768;
        if (r < 768) { p0_transpose_item(A.in[5] + 1552, 3088, 1024, 1536, Win_t, 1536, nullptr, nullptr, scr, r, lane); continue; } r -= 768;
        if (r < 512) { p0_transpose_item(A.in[15], 1024, 1024, 1024, (bf16*)(ws + OFF_WOUT), 0, A.in[11], A.in[14], scr, r, lane); continue; } r -= 512;
        if (r < 512) { p0_transpose_item(A.in[18], 1024, 1024, 1024, (bf16*)(ws + OFF_WQ), 0, A.in[16], A.in[16] + 512, scr, r, lane); continue; } r -= 512;
        if (r < 1024) { p0_transpose_item(A.in[19], 2048, 1024, 2048, (bf16*)(ws + OFF_WKV), 0, nullptr, nullptr, scr, r, lane); continue; } r -= 1024;
        if (r < 512) { p0_transpose_item(A.in[22], 1024, 1024, 1024, (bf16*)(ws + OFF_WO), 0, nullptr, nullptr, scr, r, lane); continue; } r -= 512;
        if (r < 2048) { p0_transpose_item(A.in[24], 4096, 1024, 4096, (bf16*)(ws + OFF_W1), 0, A.in[23], A.in[23] + 512, scr, r, lane); continue; } r -= 2048;
        p0_transpose_item(A.in[25], 1024, 4096, 1024, (bf16*)(ws + OFF_W2), 0, nullptr, nullptr, scr, r, lane);
    }
    const int gt = blockIdx.x * 512 + tid, NGT = G * 512;
    for (int i = gt; i < 16 * 1024; i += NGT) { const int n = i >> 10, k = i & 1023; Win_t[(size_t)(3072 + n) * 1024 + k] = (bf16)f2bf(A.in[5][(size_t)k * 3088 + 1536 + n]); }
    for (int i = gt; i < 240 * 1024 / 8; i += NGT) ((v4u*)(Win_t + (size_t)3088 * 1024))[i] = (v4u){0u, 0u, 0u, 0u};
    { f32x4* z = (f32x4*)(ws + OFF_SSQ); for (int i = gt; i < T * 8 / 4; i += NGT) z[i] = (f32x4){0.f, 0.f, 0.f, 0.f}; }
    { f32x4 g[4];
#pragma unroll
      for (int j = 0; j < 4; ++j) g[j] = ((const f32x4*)A.in[4])[lane + 64 * j];
      bf16* XN = (bf16*)ws;
      for (int m = gw; m < T; m += 4 * NGW) { const float* xr[4]; bf16* orow[4];
#pragma unroll
          for (int r = 0; r < 4; ++r) { int mm = m + r * NGW; mm = mm < T ? mm : T - 1; xr[r] = mm < TP ? A.in[0] + (size_t)mm * 1024 : A.in[1] + (size_t)(mm - TP) * 1024; orow[r] = XN + (size_t)mm * 1024; }
          rms_rows_to_bf16<4>(xr, g, orow, lane); } }
    { f32x4 g[4];
#pragma unroll
      for (int j = 0; j < 4; ++j) g[j] = ((const f32x4*)A.in[17])[lane + 64 * j];
      bf16* MEMN = (bf16*)(ws + OFF_MEMN);
      for (int m = gw; m < NMEM; m += NGW) { const float* xr[1] = {m < 512 ? A.in[2] + (size_t)m * 1024 : A.in[3] + (size_t)(m - 512) * 1024}; bf16* orow[1] = {MEMN + (size_t)m * 1024}; rms_rows_to_bf16<1>(xr, g, orow, lane); } }
}

__device__ __forceinline__ void load8(const bf16* p, float (&v)[8]) { const v4u u = *(const v4u*)p; v[0] = bflo(u.x); v[1] = bfhi(u.x); v[2] = bflo(u.y); v[3] = bfhi(u.y); v[4] = bflo(u.z); v[5] = bfhi(u.z); v[6] = bflo(u.w); v[7] = bfhi(u.w); }
__device__ __forceinline__ void store8(bf16* p, const float (&v)[8]) { v4u u; u.x = pk2(v[0], v[1]); u.y = pk2(v[2], v[3]); u.z = pk2(v[4], v[5]); u.w = pk2(v[6], v[7]); *(v4u*)p = u; }
__device__ __forceinline__ void phase_elementwise(const Args& A, int tid, int lane) {
    unsigned char* ws = A.ws;
    for (int u = blockIdx.x; u < 1536; u += gridDim.x) {
        if (u < 768) {
            const int ten = u / 384, blk = u % 384, t0 = blk * 128; int ss, L; seq_of(t0, ss, L);
            const bf16* src = (const bf16*)(ws + (3 + ten) * SLOT); bf16* dst = (bf16*)(ws + ten * SLOT);
            const int cgp = tid & 63, tg = tid >> 6, ch = ten * 512 + cgp * 8;
            float w[5][8], b[8];
#pragma unroll
            for (int k = 0; k < 5; ++k)
#pragma unroll
                for (int e = 0; e < 8; ++e) w[k][e] = A.in[6][k * 1024 + ch + e];
#pragma unroll
            for (int e = 0; e < 8; ++e) b[e] = A.in[7][ch + e];
            const int tb = t0 + tg * 16;
            v4u raw[20];
#pragma unroll
            for (int k = 0; k < 20; ++k) { const int tt = tb - 2 + k; raw[k] = (tt >= ss && tt < ss + L) ? *(const v4u*)(src + (size_t)tt * 512 + cgp * 8) : (v4u){0u, 0u, 0u, 0u}; }
#pragma unroll
            for (int i = 0; i < 16; ++i) {
                float o[8];
#pragma unroll
                for (int e = 0; e < 8; ++e) o[e] = b[e];
#pragma unroll
                for (int k = 0; k < 5; ++k) { const v4u q = raw[i + k];
                    o[0] += w[k][0] * bflo(q.x); o[1] += w[k][1] * bfhi(q.x); o[2] += w[k][2] * bflo(q.y); o[3] += w[k][3] * bfhi(q.y);
                    o[4] += w[k][4] * bflo(q.z); o[5] += w[k][5] * bfhi(q.z); o[6] += w[k][6] * bflo(q.w); o[7] += w[k][7] * bfhi(q.w); }
#pragma unroll
                for (int e = 0; e < 8; ++e) o[e] = o[e] * __builtin_amdgcn_rcpf(1.0f + __expf(-o[e]));
                store8(dst + (size_t)(tb + i) * 512 + cgp * 8, o);
            }
        } else {
            const int v = u - 768, ten = v / 384, blk = v % 384, t0 = blk * 128; int ss, L; seq_of(t0, ss, L);
            bf16* X = (bf16*)(ws + (5 + ten) * SLOT); const float* gp = A.in[12 + ten];
            const int c8 = tid & 63, sub = c8 & 7; float g[8];
#pragma unroll
            for (int e = 0; e < 8; ++e) g[e] = gp[sub * 8 + e];
            const float invf1 = exp2f(-(float)sub * 0.125f * 18.931568569324174f);
            v4u rq[16];
#pragma unroll
            for (int it = 0; it < 16; ++it) rq[it] = *(const v4u*)(X + (size_t)(t0 + it * 8 + (tid >> 6)) * 512 + c8 * 8);
#pragma unroll
            for (int it = 0; it < 16; ++it) {
                const int tok = t0 + it * 8 + (tid >> 6); bf16* p = X + (size_t)tok * 512 + c8 * 8; float x[8];
                { const v4u q = rq[it]; x[0] = bflo(q.x); x[1] = bfhi(q.x); x[2] = bflo(q.y); x[3] = bfhi(q.y); x[4] = bflo(q.z); x[5] = bfhi(q.z); x[6] = bflo(q.w); x[7] = bfhi(q.w); }
                float s = 0.f;
#pragma unroll
                for (int e = 0; e < 8; ++e) s += x[e] * x[e];
                s += __shfl_xor(s, 1); s += __shfl_xor(s, 2); s += __shfl_xor(s, 4);
                const float rs = 1.0f / sqrtf(s * (1.0f / 64.0f) + EPS);
#pragma unroll
                for (int e = 0; e < 8; ++e) x[e] = x[e] * rs * g[e];
                float o[8]; const float pos = (float)(tok - ss);
                float sn1, cs1;
                { const float ang = pos * invf1; const double rev = (double)ang * 0.15915494309189535; const float fr = (float)(rev - rint(rev)); sn1 = __builtin_amdgcn_sinf(fr); cs1 = __builtin_amdgcn_cosf(fr); }
#pragma unroll
                for (int e = 0; e < 8; ++e) { const float other = __shfl_xor(x[e], 1); const float sn = __shfl(sn1, (lane & ~7) + e), cs = __shfl(cs1, (lane & ~7) + e);
                    o[e] = sub == 0 ? x[e] * cs - other * sn : (sub == 1 ? x[e] * cs + other * sn : x[e]); }
                store8(p, o);
            }
        }
    }
}
__device__ __forceinline__ void phase_kxnorm(const Args& A, int tid) {
    unsigned char* ws = A.ws;
    for (int u = blockIdx.x; u < 640; u += gridDim.x) {
        {
            const int v = u; const int item = v * 16 + (tid >> 5), l5 = tid & 31; const int row = item >> 2, hd = item & 3;
            bf16* p = (bf16*)(ws + OFF_KX) + (size_t)row * 1024 + hd * 256 + l5 * 8; float x[8]; load8(p, x);
            float s = 0.f;
#pragma unroll
            for (int e = 0; e < 8; ++e) s += x[e] * x[e];
            s += __shfl_xor(s, 1); s += __shfl_xor(s, 2); s += __shfl_xor(s, 4); s += __shfl_xor(s, 8); s += __shfl_xor(s, 16);
            const float rs = 1.0f / sqrtf(s * (1.0f / 256.0f) + EPS);
#pragma unroll
            for (int e = 0; e < 8; ++e) x[e] = x[e] * rs * A.in[21][l5 * 8 + e] * A.in[20][l5 * 8 + e];
            store8(p, x);
        }
    }
}
#define XB_TMO      128
#define XB_XCNT(j)  (256  + 64 * (j))
#define XB_XSUB(j)  (1280 + 64 * (j))
#define XB_XGEN(j)  (2304 + 64 * (j))
#define XB_TOP      3328
#define XB_TOPGEN   3392
#define XCD_BAR_WORDS 3456
#define XB_SPIN_CAP (1u << 18)

__device__ __forceinline__ unsigned xb_ld(unsigned* p)              { return __hip_atomic_load(p, __ATOMIC_RELAXED, __HIP_MEMORY_SCOPE_AGENT); }
__device__ __forceinline__ unsigned xb_add(unsigned* p, unsigned v) { return __hip_atomic_fetch_add(p, v, __ATOMIC_RELAXED, __HIP_MEMORY_SCOPE_AGENT); }
__device__ __forceinline__ unsigned xb_xcc_id() { return (unsigned)__builtin_amdgcn_s_getreg((3 << 11) | 20) & 0xFu; }
#define XB_SPIN(cond, bar) do { unsigned _sp = 0; while (cond) { __builtin_amdgcn_s_sleep(1); \
    if ((++_sp & 255u) == 0u) { if (xb_ld(&(bar)[XB_TMO])) break; if (_sp > XB_SPIN_CAP) { atomicAdd(&(bar)[XB_TMO], 1u); break; } } } } while (0)

struct XcdBarrier {
    unsigned* bar; unsigned x;
    volatile LAS unsigned* st;
};

__device__ __forceinline__ XcdBarrier xcd_barrier_post(unsigned* bar, volatile LAS unsigned* st) {
    XcdBarrier b; b.bar = bar; b.x = xb_xcc_id(); b.st = st;
    if (threadIdx.x == 0) st[4] = xb_add(&bar[XB_XCNT(b.x)], 1u);
    return b;
}
__device__ __forceinline__ void xcd_barrier_complete(unsigned* bar, unsigned x, unsigned& nloc, unsigned& nx) {
    const unsigned G = gridDim.x * gridDim.y * gridDim.z;
    unsigned sum, cnt, mine, sp = 0u;
    for (;;) {
        sum = 0u; cnt = 0u; mine = 0u;
#pragma unroll
        for (unsigned j = 0; j < 16; ++j) { const unsigned c = xb_ld(&bar[XB_XCNT(j)]); sum += c; cnt += (c > 0u) ? 1u : 0u; mine = (j == x) ? c : mine; }
        if (sum == G) break;
        __builtin_amdgcn_s_sleep(1);
        if ((++sp & 255u) == 0u) { if (xb_ld(&bar[XB_TMO])) break; if (sp > XB_SPIN_CAP) { atomicAdd(&bar[XB_TMO], 1u); break; } }
    }
    nloc = mine > 0u ? mine : 1u; nx = cnt > 0u ? cnt : 1u;
}

__device__ __forceinline__ void xcd_barrier(const XcdBarrier& b) {
    asm volatile("s_waitcnt vmcnt(0)" ::: "memory");
    __syncthreads();
    if (threadIdx.x == 0) {
        unsigned* bar = b.bar;
        __builtin_amdgcn_s_waitcnt(0);
        unsigned nloc = b.st[0], nx = b.st[1];
        if (nloc == 0u) { xcd_barrier_complete(bar, b.x, nloc, nx); b.st[0] = nloc; b.st[1] = nx; }
        const unsigned old = xb_add(&bar[XB_XSUB(b.x)], 1u);
        const unsigned gen = old / nloc;
        if (old + 1u == (gen + 1u) * nloc) {
            __builtin_amdgcn_fence(__ATOMIC_RELEASE, "agent");
            asm volatile("s_waitcnt vmcnt(0)" ::: "memory");
            const unsigned og = xb_add(&bar[XB_TOP], 1u);
            const unsigned tg = og / nx;
            if (og + 1u == (tg + 1u) * nx) xb_add(&bar[XB_TOPGEN], 1u);
            else XB_SPIN(xb_ld(&bar[XB_TOPGEN]) == tg, bar);
            __builtin_amdgcn_fence(__ATOMIC_ACQUIRE, "agent");
            xb_add(&bar[XB_XGEN(b.x)], 1u);
            asm volatile("s_waitcnt vmcnt(0)" ::: "memory");
        } else {
            XB_SPIN(xb_ld(&bar[XB_XGEN(b.x)]) == gen, bar);
            __builtin_amdgcn_fence(__ATOMIC_ACQUIRE, "agent");
            asm volatile("s_waitcnt vmcnt(0)" ::: "memory");
        }
    }
    __syncthreads();
}
constexpr int L_VDT = 0, L_VCUM = 4096, L_VTOT = 8192, L_BIMG = 9216, BSTR = 272, XSTR = 144;
constexpr int L_XF = L_BIMG + 128 * BSTR  , L_XB = L_XF + 128 * XSTR  ;
constexpr int L_CIMG = L_BIMG + 128 * BSTR  , L_XIMG = L_CIMG + 128 * BSTR  , L_PIMG = L_XIMG + 128 * XSTR  ;
__device__ __forceinline__ void ssd_vectors(const Args& A, LAS unsigned char* lds, int t0, int g, int wave, int lane) {
    const int hh = wave >> 1, dir = wave & 1, head = 4 * g + hh;
    const float* DT = (const float*)(A.ws + OFF_DT);
    const float bias = A.in[9][dir * 8 + head], Aneg = -__expf(A.in[8][dir * 8 + head]);
    float d[2], a[2];
#pragma unroll
    for (int k = 0; k < 2; ++k) { const float x = DT[(size_t)(t0 + 2 * lane + k) * 16 + dir * 8 + head] + bias; d[k] = x > 20.f ? x : log1pf(__expf(x)); a[k] = d[k] * Aneg; }
    const float ps = a[0] + a[1]; float inc = ps;
#pragma unroll
    for (int o = 1; o < 64; o <<= 1) { const float y = __shfl_up(inc, o); if (lane >= o) inc += y; }
    const float exc = inc - ps; const float tot = __shfl(inc, 63);
    LAS float* vdt = (LAS float*)(lds + L_VDT) + (hh * 2 + dir) * 128; LAS float* vc = (LAS float*)(lds + L_VCUM) + (hh * 2 + dir) * 128;
    vdt[2 * lane] = d[0]; vdt[2 * lane + 1] = d[1];
    if (dir == 0) { vc[2 * lane] = exc + a[0]; vc[2 * lane + 1] = inc; } else { vc[2 * lane] = exc; vc[2 * lane + 1] = exc + a[0]; }
    if (lane == 0) ((LAS float*)(lds + L_VTOT))[hh * 2 + dir] = tot;
}
__device__ __forceinline__ void stage_rows128(const bf16* src, int ld, LAS unsigned char* img, int tid) {
#pragma unroll
    for (int i = 0; i < 4; ++i) { const int idx = tid + 512 * i, row = idx >> 4, ch = idx & 15; *(LAS v4u*)(img + row * BSTR + ch * 16) = *(const v4u*)(src + (size_t)row * ld + ch * 8); }
}
__device__ __forceinline__ void ssd_states_unit(const Args& A, LAS unsigned char* lds, int c, int g, int tid, int lane, int wave) {
    unsigned char* ws = A.ws; const int t0 = c * 128;
    const bf16* XS = (const bf16*)ws; const bf16* BC = (const bf16*)(ws + SLOT); bf16* ST = (bf16*)A.out;
    v4u xall[4][2];
#pragma unroll
    for (int hh = 0; hh < 4; ++hh)
#pragma unroll
        for (int h2 = 0; h2 < 2; ++h2) xall[hh][h2] = *(const v4u*)(XS + (size_t)(t0 + (tid >> 2)) * 512 + (4 * g + hh) * 64 + (tid & 3) * 16 + 8 * h2);
    ssd_vectors(A, lds, t0, g, wave, lane);
    stage_rows128(BC + (size_t)t0 * 512 + g * 128, 512, lds + L_BIMG, tid);
    LDSW(); __syncthreads();
    if (tid < 8) ((float*)(ws + OFF_DEC))[(c * 8 + 4 * g + (tid >> 1)) * 2 + (tid & 1)] = __expf(((LAS float*)(lds + L_VTOT))[tid]);
    const int kg = lane >> 4;
#pragma unroll
    for (int hh = 0; hh < 4; ++hh) {
        const int head = 4 * g + hh;
        { const int j = tid >> 2, c0 = (tid & 3) * 16; const LAS float* vdt = (LAS float*)(lds + L_VDT) + hh * 256; const LAS float* vc = (LAS float*)(lds + L_VCUM) + hh * 256;
          const float wf = __expf(fminf(((LAS float*)(lds + L_VTOT))[hh * 2] - vc[j], 0.f)) * vdt[j], wb = __expf(fminf(vc[128 + j], 0.f)) * vdt[128 + j];
#pragma unroll
          for (int h2 = 0; h2 < 2; ++h2) { float x[8]; { const v4u q = xall[hh][h2]; x[0] = bflo(q.x); x[1] = bfhi(q.x); x[2] = bflo(q.y); x[3] = bfhi(q.y); x[4] = bflo(q.z); x[5] = bfhi(q.z); x[6] = bflo(q.w); x[7] = bfhi(q.w); } v4u f, b;
              f.x = pk2(x[0] * wf, x[1] * wf); f.y = pk2(x[2] * wf, x[3] * wf); f.z = pk2(x[4] * wf, x[5] * wf); f.w = pk2(x[6] * wf, x[7] * wf);
              b.x = pk2(x[0] * wb, x[1] * wb); b.y = pk2(x[2] * wb, x[3] * wb); b.z = pk2(x[4] * wb, x[5] * wb); b.w = pk2(x[6] * wb, x[7] * wb);
              *(LAS v4u*)(lds + L_XF + j * XSTR + (c0 + 8 * h2) * 2) = f; *(LAS v4u*)(lds + L_XB + j * XSTR + (c0 + 8 * h2) * 2) = b; } }
        LDSW(); __syncthreads();
        const int dir = wave >> 2, nt0 = (wave & 3) * 2; LAS unsigned char* ximg = lds + (dir ? L_XB : L_XF);
        f32x4 acc[4][2];
#pragma unroll
        for (int pt = 0; pt < 4; ++pt)
#pragma unroll
            for (int nt = 0; nt < 2; ++nt) acc[pt][nt] = (f32x4){0.f, 0.f, 0.f, 0.f};
#pragma unroll
        for (int ks = 0; ks < 4; ++ks) {
            bf16x8 af[4], bfr[2]; const int r0 = 32 * ks + 8 * kg;
#pragma unroll
            for (int pt = 0; pt < 4; ++pt) af[pt] = tr_frag(ximg, XSTR, r0, r0 + 4, 16 * pt, lane);
#pragma unroll
            for (int nt = 0; nt < 2; ++nt) bfr[nt] = tr_frag(lds + L_BIMG, BSTR, r0, r0 + 4, 16 * (nt0 + nt), lane);
#pragma unroll
            for (int pt = 0; pt < 4; ++pt)
#pragma unroll
                for (int nt = 0; nt < 2; ++nt) acc[pt][nt] = MFMA16(af[pt], bfr[nt], acc[pt][nt]);
        }
        bf16* sp = ST + (size_t)((c * 8 + head) * 2 + dir) * 8192;
#pragma unroll
        for (int pt = 0; pt < 4; ++pt)
#pragma unroll
            for (int nt = 0; nt < 2; ++nt)
#pragma unroll
                for (int e = 0; e < 4; ++e) sp[(16 * pt + 4 * kg + e) * 128 + 16 * (nt0 + nt) + (lane & 15)] = (bf16)f2bf(acc[pt][nt][e]);
        LDSW(); __syncthreads();
    }
}
template <int NV> __device__ __forceinline__ void scan_task(bf16* ST, const float* DEC, int c0, int nc, int head, int dir, int eoff) {
    float carry[8 * NV];
#pragma unroll
    for (int e = 0; e < 8 * NV; ++e) carry[e] = 0.f;
    for (int k = 0; k < nc; k += 8) {
        v4u sv[8][NV]; float dc[8];
#pragma unroll
        for (int u = 0; u < 8; ++u) { const int c = dir ? c0 + nc - 1 - (k + u) : c0 + k + u; const bf16* p = ST + (size_t)((c * 8 + head) * 2 + dir) * 8192 + eoff;
#pragma unroll
            for (int h = 0; h < NV; ++h) sv[u][h] = *(const v4u*)(p + 8 * h);
            dc[u] = DEC[(c * 8 + head) * 2 + dir]; }
#pragma unroll
        for (int u = 0; u < 8; ++u) { const int c = dir ? c0 + nc - 1 - (k + u) : c0 + k + u; bf16* p = ST + (size_t)((c * 8 + head) * 2 + dir) * 8192 + eoff;
#pragma unroll
            for (int h = 0; h < NV; ++h) { v4u o; o.x = pk2(carry[8 * h], carry[8 * h + 1]); o.y = pk2(carry[8 * h + 2], carry[8 * h + 3]); o.z = pk2(carry[8 * h + 4], carry[8 * h + 5]); o.w = pk2(carry[8 * h + 6], carry[8 * h + 7]); *(v4u*)(p + 8 * h) = o;
                const v4u s_ = sv[u][h]; const float d = dc[u];
                carry[8 * h] = carry[8 * h] * d + bflo(s_.x); carry[8 * h + 1] = carry[8 * h + 1] * d + bfhi(s_.x); carry[8 * h + 2] = carry[8 * h + 2] * d + bflo(s_.y); carry[8 * h + 3] = carry[8 * h + 3] * d + bfhi(s_.y);
                carry[8 * h + 4] = carry[8 * h + 4] * d + bflo(s_.z); carry[8 * h + 5] = carry[8 * h + 5] * d + bfhi(s_.z); carry[8 * h + 6] = carry[8 * h + 6] * d + bflo(s_.w); carry[8 * h + 7] = carry[8 * h + 7] * d + bfhi(s_.w); } }
    }
}
__device__ __forceinline__ void phase_scan(const Args& A, int tid) {
    bf16* ST = (bf16*)A.out; const float* DEC = (const float*)(A.ws + OFF_DEC);
    for (int idx = blockIdx.x * 512 + tid; idx < 98304; idx += gridDim.x * 512) {
        if (idx < 32768) { const int e8 = idx & 1023, dir = (idx >> 10) & 1, head = (idx >> 11) & 7, sq = idx >> 14; scan_task<1>(ST, DEC, sq * 64, 64, head, dir, e8 * 8); }
        else { const int j = idx - 32768; const int e16 = j & 511, dir = (j >> 9) & 1, head = (j >> 10) & 7, sq = j >> 13; scan_task<2>(ST, DEC, 128 + sq * 32, 32, head, dir, e16 * 16); }
    }
}
__device__ __forceinline__ void ssd_out_unit(const Args& A, LAS unsigned char* lds, int c, int g, int tid, int lane, int wave) {
    unsigned char* ws = A.ws; const int t0 = c * 128;
    const bf16* XS = (const bf16*)ws; const bf16* BC = (const bf16*)(ws + SLOT); const bf16* Z = (const bf16*)(ws + 2 * SLOT); const bf16* ST = (const bf16*)A.out;
    bf16* MIX = (bf16*)(ws + 3 * SLOT); float* ssq = (float*)(ws + OFF_SSQ) + (size_t)T * 6;
    ssd_vectors(A, lds, t0, g, wave, lane);
    stage_rows128(BC + (size_t)t0 * 512 + g * 128, 512, lds + L_BIMG, tid);
    stage_rows128(BC + (size_t)t0 * 512 + 256 + g * 128, 512, lds + L_CIMG, tid);
    LDSW(); __syncthreads();
    const int kg = lane >> 4, l15 = lane & 15, il = 16 * wave + l15;
    bf16x8 cf[4];
#pragma unroll
    for (int ks = 0; ks < 4; ++ks) cf[ks] = *(const LAS bf16x8*)(lds + L_CIMG + il * BSTR + (32 * ks + 8 * kg) * 2);
    f32x4 cb[8];
#pragma unroll
    for (int jt = 0; jt < 8; ++jt) { cb[jt] = (f32x4){0.f, 0.f, 0.f, 0.f};
#pragma unroll
        for (int ks = 0; ks < 4; ++ks) { const bf16x8 bf_ = *(const LAS bf16x8*)(lds + L_BIMG + (16 * jt + l15) * BSTR + (32 * ks + 8 * kg) * 2); cb[jt] = MFMA16(bf_, cf[ks], cb[jt]); } }
    float ssqa[4] = {0.f, 0.f, 0.f, 0.f};
    v4u xr[2], pr[4];
    {
#pragma unroll
        for (int i = 0; i < 2; ++i) { const int idx = tid + 512 * i, row = idx >> 3, ch = idx & 7; xr[i] = *(const v4u*)(XS + (size_t)(t0 + row) * 512 + (4 * g) * 64 + ch * 8); }
        const bf16* sp = ST + (size_t)((c * 8 + 4 * g) * 2) * 8192;
#pragma unroll
        for (int i = 0; i < 4; ++i) pr[i] = *(const v4u*)(sp + (size_t)(tid + 512 * i) * 8);
    }
    for (int hh = 0; hh < 4; ++hh) {
        const int head = 4 * g + hh;
        bf16 zr[4][4];
        __syncthreads();
#pragma unroll
        for (int e = 0; e < 4; ++e)
#pragma unroll
            for (int pt = 0; pt < 4; ++pt) zr[e][pt] = Z[(size_t)(t0 + 16 * wave + 4 * kg + e) * 512 + head * 64 + 16 * pt + l15];
#pragma unroll
        for (int i = 0; i < 2; ++i) { const int idx = tid + 512 * i, row = idx >> 3, ch = idx & 7; *(LAS v4u*)(lds + L_XIMG + row * XSTR + ch * 16) = xr[i]; }
#pragma unroll
        for (int i = 0; i < 4; ++i) { const int idx = tid + 512 * i, row = idx >> 4, ch = idx & 15; *(LAS v4u*)(lds + L_PIMG + row * BSTR + ch * 16) = pr[i]; }
        if (hh < 3) {
#pragma unroll
            for (int i = 0; i < 2; ++i) { const int idx = tid + 512 * i, row = idx >> 3, ch = idx & 7; xr[i] = *(const v4u*)(XS + (size_t)(t0 + row) * 512 + (head + 1) * 64 + ch * 8); }
            const bf16* sp = ST + (size_t)((c * 8 + head + 1) * 2) * 8192;
#pragma unroll
            for (int i = 0; i < 4; ++i) pr[i] = *(const v4u*)(sp + (size_t)(tid + 512 * i) * 8);
        }
        LDSW(); __syncthreads();
        const LAS float* vdtf = (LAS float*)(lds + L_VDT) + hh * 256; const LAS float* vdtb = vdtf + 128;
        const LAS float* vcf = (LAS float*)(lds + L_VCUM) + hh * 256; const LAS float* vcb = vcf + 128;
        const float acf_i = vcf[il], ecb_i = vcb[il], Dh = A.in[10][head], totb = ((LAS float*)(lds + L_VTOT))[hh * 2 + 1];
        f32x4 Y[4];
#pragma unroll
        for (int pt = 0; pt < 4; ++pt) Y[pt] = (f32x4){0.f, 0.f, 0.f, 0.f};
#pragma unroll
        for (int ks = 0; ks < 4; ++ks) {
            f32x4 wv[2];
#pragma unroll
            for (int h2 = 0; h2 < 2; ++h2) { const int jt = 2 * ks + h2, j0 = 16 * jt + 4 * kg;
                const f32x4 cfj = *(const LAS f32x4*)(vcf + j0), dfj = *(const LAS f32x4*)(vdtf + j0), cbj = *(const LAS f32x4*)(vcb + j0), dbj = *(const LAS f32x4*)(vdtb + j0);
                if (jt < wave) {
#pragma unroll
                    for (int e = 0; e < 4; ++e) wv[h2][e] = cb[jt][e] * (__expf(fminf(acf_i - cfj[e], 0.f)) * dfj[e]);
                } else if (jt > wave) {
#pragma unroll
                    for (int e = 0; e < 4; ++e) wv[h2][e] = cb[jt][e] * (__expf(fminf(cbj[e] - ecb_i, 0.f)) * dbj[e]);
                } else {
#pragma unroll
                    for (int e = 0; e < 4; ++e) { const int j = j0 + e;
                        const float mf = j <= il ? __expf(fminf(acf_i - cfj[e], 0.f)) * dfj[e] : 0.f, mb = j >= il ? __expf(fminf(cbj[e] - ecb_i, 0.f)) * dbj[e] : 0.f;
                        wv[h2][e] = cb[jt][e] * (mf + mb) + (j == il ? Dh : 0.f); } } }
            const bf16x8 wf = pack8(wv[0], wv[1]);
#pragma unroll
            for (int pt = 0; pt < 4; ++pt) { const bf16x8 xf = tr_frag(lds + L_XIMG, XSTR, 32 * ks + 4 * kg, 32 * ks + 16 + 4 * kg, 16 * pt, lane); Y[pt] = MFMA16(wf, xf, Y[pt]); }
        }
#pragma unroll
        for (int dir = 0; dir < 2; ++dir) {
            f32x4 a2[4];
#pragma unroll
            for (int pt = 0; pt < 4; ++pt) a2[pt] = (f32x4){0.f, 0.f, 0.f, 0.f};
#pragma unroll
            for (int ks = 0; ks < 4; ++ks)
#pragma unroll
                for (int pt = 0; pt < 4; ++pt) { const bf16x8 pf = *(const LAS bf16x8*)(lds + L_PIMG + (dir * 64 + 16 * pt + l15) * BSTR + (32 * ks + 8 * kg) * 2); a2[pt] = MFMA16(cf[ks], pf, a2[pt]); }
            const f32x4 cv = *(const LAS f32x4*)((dir ? vcb : vcf) + 16 * wave + 4 * kg);
#pragma unroll
            for (int e = 0; e < 4; ++e) { const float sc = dir ? __expf(fminf(totb - cv[e], 0.f)) : __expf(fminf(cv[e], 0.f));
#pragma unroll
                for (int pt = 0; pt < 4; ++pt) Y[pt][e] += sc * a2[pt][e]; }
        }
#pragma unroll
        for (int e = 0; e < 4; ++e) { const size_t tok = (size_t)(t0 + 16 * wave + 4 * kg + e);
#pragma unroll
            for (int pt = 0; pt < 4; ++pt) { const int col = head * 64 + 16 * pt + l15; const float z = bf1(zr[e][pt]); const float y = Y[pt][e] * z * __builtin_amdgcn_rcpf(1.0f + __expf(-z));
                ssqa[e] += y * y; MIX[tok * 1024 + col] = (bf16)f2bf(y); } }
    }
#pragma unroll
    for (int e = 0; e < 4; ++e) { float s = ssqa[e]; s += __shfl_xor(s, 1); s += __shfl_xor(s, 2); s += __shfl_xor(s, 4); s += __shfl_xor(s, 8);
        if (l15 == 0) unsafeAtomicAdd(ssq + t0 + 16 * wave + 4 * kg + e, s); }
    __syncthreads();
}
constexpr int L_ACC = 0, ACCSTR = 272, L_DEN = 256 * ACCSTR  , L_VST = L_DEN + 1024  , VSTR = 144, VST_BYTES = 32 * VSTR;
struct DG { int dsh, r, m0, Lc, mtl; };
__device__ __forceinline__ DG dgeom(int task, int wave, int tb, int ss, int L) {
    DG g; const int pi = task < 2 ? task : 2; g.dsh = 2 * pi; const int qt = 2 * wave + (task == 3 ? 1 : 0); const int tsh = 4 - g.dsh;
    g.r = qt >> tsh; const int mt = qt & ((1 << tsh) - 1); g.mtl = 16 * mt; g.m0 = ((tb - ss) >> g.dsh) + g.mtl; g.Lc = L >> g.dsh; return g; }
__device__ __forceinline__ void dkload(const bf16* K, int head, int ss, const DG& g, int c, int lane, bf16x8 (&kk)[4]) {
    const int kg = lane >> 4, l15 = lane & 15;
#pragma unroll
    for (int t = 0; t < 2; ++t) { int mk = g.m0 - 64 + 32 * c + 16 * t + l15; mk = mk < 0 ? 0 : (mk > g.Lc - 1 ? g.Lc - 1 : mk); const unsigned ko = (unsigned)(((ss + (mk << g.dsh) + g.r) * 512 + head * 64 + 8 * kg) * 2);
        kk[2 * t] = *(const bf16x8*)((const char*)K + ko); kk[2 * t + 1] = *(const bf16x8*)((const char*)K + ko + 64); }
}
template <bool TWO, bool HASNEXT> __device__ __forceinline__ void dtask(const bf16* Q, const bf16* K, const bf16* V, int head, int ss, const DG& g, const DG& gn, bf16x8 (&kk)[5][4], bf16x8 (&kn)[5][4],
                                                                        LAS unsigned char* lds, LAS unsigned char* vst, float c1, float c2, int lane) {
    constexpr int NQ = TWO ? 2 : 1; const int kg = lane >> 4, l15 = lane & 15;
    bf16x8 qf[NQ][2];
#pragma unroll
    for (int j = 0; j < NQ; ++j) { const int tokq = ss + ((g.m0 + 16 * j + l15) << g.dsh) + g.r;
#pragma unroll
        for (int ks = 0; ks < 2; ++ks) qf[j][ks] = *(const bf16x8*)((const char*)Q + (unsigned)((tokq * 512 + head * 64 + 32 * ks + 8 * kg) * 2)); }
    float den[NQ]; f32x4 O[NQ][4];
#pragma unroll
    for (int j = 0; j < NQ; ++j) { den[j] = 0.f;
#pragma unroll
        for (int dt = 0; dt < 4; ++dt) O[j][dt] = (f32x4){0.f, 0.f, 0.f, 0.f}; }
#pragma unroll
    for (int grp = 0; grp < 3; ++grp) {
        const int cb = grp * 2, ce = grp == 2 ? 5 : cb + 2;
        bf16x8 kq[2][4]; bf16x8 pf[2][NQ]; v4u vv[2][4];
#pragma unroll
        for (int c = cb; c < ce; ++c) dkload(K, head, ss, g, c, lane, kq[c - cb]);
#pragma unroll
        for (int c = cb; c < ce; ++c) {
            const int kb = g.m0 - 64 + 32 * c;
#pragma unroll
            for (int j = 0; j < NQ; ++j) { f32x4 st[2]; const int mq = g.m0 + 16 * j + l15; const int klo = mq - 64 > 0 ? mq - 64 : 0, khi = mq + 64 < g.Lc - 1 ? mq + 64 : g.Lc - 1; const unsigned kspan = (unsigned)(khi - klo);
#pragma unroll
                for (int t = 0; t < 2; ++t) { st[t] = MFMA16(kq[c - cb][2 * t], qf[j][0], ((f32x4){0.f, 0.f, 0.f, 0.f})); st[t] = MFMA16(kq[c - cb][2 * t + 1], qf[j][1], st[t]); }
#pragma unroll
                for (int t = 0; t < 2; ++t)
#pragma unroll
                    for (int e = 0; e < 4; ++e) { const int mk = kb + 16 * t + 4 * kg + e; const bool ok = (unsigned)(mk - klo) <= kspan;
                        const float p = ok ? __builtin_amdgcn_exp2f(st[t][e] * c1 - c2) : 0.f; st[t][e] = p; den[j] += p; }
                pf[c - cb][j] = pack8(st[0], st[1]); }
        }
        asm volatile("" ::: "memory");
#pragma unroll
        for (int c = cb; c < ce; ++c) {
            const int kb = g.m0 - 64 + 32 * c;
#pragma unroll
            for (int i = 0; i < 4; ++i) { int mk = kb + (lane >> 3) + 8 * i; mk = mk < 0 ? 0 : (mk > g.Lc - 1 ? g.Lc - 1 : mk); vv[c - cb][i] = *(const v4u*)((const char*)V + (unsigned)(((ss + (mk << g.dsh) + g.r) * 512 + head * 64 + 8 * (lane & 7)) * 2)); }
        }
#pragma unroll
        for (int c = cb; c < ce; ++c) {
            LDSW();
#pragma unroll
            for (int i = 0; i < 4; ++i) *(LAS v4u*)(vst + ((lane >> 3) + 8 * i) * VSTR + (lane & 7) * 16) = vv[c - cb][i];
            LDSW();
#pragma unroll
            for (int dt = 0; dt < 4; ++dt) { const bf16x8 vf = tr_frag(vst, VSTR, 4 * kg, 16 + 4 * kg, 16 * dt, lane);
#pragma unroll
                for (int j = 0; j < NQ; ++j) O[j][dt] = MFMA16(vf, pf[c - cb][j], O[j][dt]); }
        }
    }
#pragma unroll
    for (int j = 0; j < NQ; ++j) { float d = den[j]; d += __shfl_xor(d, 16); d += __shfl_xor(d, 32);
        const int tl = ((g.mtl + 16 * j + l15) << g.dsh) + g.r;
#pragma unroll
        for (int dt = 0; dt < 4; ++dt) { LAS f32x4* ap = (LAS f32x4*)(lds + L_ACC + tl * ACCSTR + (16 * dt + 4 * kg) * 4); *ap = *ap + O[j][dt]; }
        if (kg == 0) { LAS float* dp = (LAS float*)(lds + L_DEN) + tl; *dp = *dp + d; } }
}
#define DBAR() do { LDSW(); __builtin_amdgcn_s_barrier(); asm volatile("" ::: "memory"); } while (0)
constexpr int GSTR = 144;
template <int HPC> __device__ __forceinline__ void dstage(const bf16* X, int head, int ss, int Lc, int dsh, int ra, int mbase, LAS unsigned char* img, int row0, int tid) {
    v4u v[6];
#pragma unroll
    for (int i = 0; i < 6; ++i) { const int idx = tid + 512 * i, row = idx >> 3, ch = idx & 7; const int cls = row / HPC; int mk = mbase + (row - cls * HPC); mk = mk < 0 ? 0 : (mk > Lc - 1 ? Lc - 1 : mk);
        v[i] = *(const v4u*)((const char*)X + (unsigned)(((ss + (mk << dsh) + ra + cls) * 512 + head * 64 + ch * 8) * 2)); }
#pragma unroll
    for (int i = 0; i < 6; ++i) { const int idx = tid + 512 * i, row = idx >> 3, ch = idx & 7; *(LAS v4u*)(img + (row0 + row) * GSTR + ch * 16) = v[i]; }
}
template <int NQ> __device__ __forceinline__ void dfused(const bf16* Q, int head, int ss, const DG& g, int krow0, LAS unsigned char* img, float c1, float c2, int lane, f32x4 (&O)[NQ][4], float (&den)[NQ]) {
    const int kg = lane >> 4, l15 = lane & 15;
    bf16x8 qf[NQ][2]; unsigned klo[NQ], kspan[NQ];
#pragma unroll
    for (int j = 0; j < NQ; ++j) { const int mq = g.m0 + 16 * j + l15; const int tokq = ss + (mq << g.dsh) + g.r;
#pragma unroll
        for (int ks = 0; ks < 2; ++ks) qf[j][ks] = *(const bf16x8*)((const char*)Q + (unsigned)((tokq * 512 + head * 64 + 32 * ks + 8 * kg) * 2));
        const int lo = mq - 64 > 0 ? mq - 64 : 0, hi = mq + 64 < g.Lc - 1 ? mq + 64 : g.Lc - 1; klo[j] = (unsigned)lo; kspan[j] = (unsigned)(hi - lo); den[j] = 0.f;
#pragma unroll
        for (int dt = 0; dt < 4; ++dt) O[j][dt] = (f32x4){0.f, 0.f, 0.f, 0.f}; }
#pragma unroll 1
    for (int c = 0; c < 5; ++c) {
        const int kb = g.m0 - 64 + 32 * c; const int row = krow0 + 32 * c;
        const int t1 = (NQ == 1 && c == 4) ? 0 : 16;
        bf16x8 kf[2][2];
#pragma unroll
        for (int t = 0; t < 2; ++t) { const LAS unsigned char* kp = img + (row + t1 * t + l15) * GSTR + kg * 16; kf[t][0] = *(const LAS bf16x8*)kp; kf[t][1] = *(const LAS bf16x8*)(kp + 64); }
        bf16x8 pf[NQ];
#pragma unroll
        for (int j = 0; j < NQ; ++j) { f32x4 st[2];
#pragma unroll
            for (int t = 0; t < 2; ++t) { st[t] = MFMA16(kf[t][0], qf[j][0], ((f32x4){0.f, 0.f, 0.f, 0.f})); st[t] = MFMA16(kf[t][1], qf[j][1], st[t]); }
#pragma unroll
            for (int t = 0; t < 2; ++t)
#pragma unroll
                for (int e = 0; e < 4; ++e) { const int mk = kb + 16 * t + 4 * kg + e; const bool ok = ((unsigned)mk - klo[j]) <= kspan[j];
                    const float p = ok ? __builtin_amdgcn_exp2f(st[t][e] * c1 - c2) : 0.f; st[t][e] = p; den[j] += p; }
            pf[j] = pack8(st[0], st[1]); }
#pragma unroll
        for (int dt = 0; dt < 4; ++dt) { const bf16x8 vf = tr_frag(img, GSTR, 384 + row + 4 * kg, 384 + row + t1 + 4 * kg, 16 * dt, lane);
#pragma unroll
            for (int j = 0; j < NQ; ++j) O[j][dt] = MFMA16(vf, pf[j], O[j][dt]); }
    }
#pragma unroll
    for (int j = 0; j < NQ; ++j) { float d = den[j]; d += __shfl_xor(d, 16); d += __shfl_xor(d, 32); den[j] = d; }
}
__device__ __forceinline__ void dattn_unit(const Args& A, LAS unsigned char* lds, int blk, int head, int tid, int lane, int wave, int flags) {
    unsigned char* ws = A.ws; const int tb = blk * 256; int ss, L; seq_of(tb, ss, L);
    const bf16* Q = (const bf16*)(ws + 5 * SLOT); const bf16* K = (const bf16*)(ws + 6 * SLOT); const bf16* V = (const bf16*)(ws + 7 * SLOT);
    bf16* MIX = (bf16*)(ws + 3 * SLOT); float* ssq = (float*)(ws + OFF_SSQ) + (size_t)T * 7;
    LAS unsigned char* vst = lds + L_VST + wave * VST_BYTES;
    const int kg = lane >> 4, l15 = lane & 15, pos0 = tb - ss;
    const DG g2 = dgeom(2, wave, tb, ss, L), g3 = dgeom(3, wave, tb, ss, L);
    bf16x8 ka[5][4];
    const float mq_ = wave_max(fabsf(A.in[12][lane])), mk_ = wave_max(fabsf(A.in[13][lane]));
    const float c1 = 0.125f * LOG2E, c2 = 8.0f * mq_ * mk_ * LOG2E;
    f32x4 O1[2][4], O2a[1][4], O2b[1][4]; float den1[2], den2a[1], den2b[1];
    DG gp1; gp1.dsh = 0; gp1.r = 0; gp1.mtl = 32 * wave; gp1.m0 = pos0 + 32 * wave; gp1.Lc = L;
    dstage<384>(K, head, ss, L, 0, 0, pos0 - 64, lds, 0, tid); asm volatile("" ::: "memory");
    dstage<384>(V, head, ss, L, 0, 0, pos0 - 64, lds, 384, tid);
    DBAR();
    dfused<2>(Q, head, ss, gp1, 32 * wave, lds, c1, c2, lane, O1, den1);
    DBAR();
    DG gp2; gp2.dsh = 2; gp2.mtl = 16 * (wave & 3); gp2.m0 = (pos0 >> 2) + gp2.mtl; gp2.Lc = L >> 2;
    gp2.r = wave >> 2;
    dstage<192>(K, head, ss, L >> 2, 2, 0, (pos0 >> 2) - 64, lds, 0, tid); asm volatile("" ::: "memory");
    dstage<192>(V, head, ss, L >> 2, 2, 0, (pos0 >> 2) - 64, lds, 384, tid);
    DBAR();
    dfused<1>(Q, head, ss, gp2, 192 * (wave >> 2) + 16 * (wave & 3), lds, c1, c2, lane, O2a, den2a);
    DBAR();
    dstage<192>(K, head, ss, L >> 2, 2, 2, (pos0 >> 2) - 64, lds, 0, tid); asm volatile("" ::: "memory");
    dstage<192>(V, head, ss, L >> 2, 2, 2, (pos0 >> 2) - 64, lds, 384, tid);
    DBAR();
    gp2.r = 2 + (wave >> 2);
    dfused<1>(Q, head, ss, gp2, 192 * (wave >> 2) + 16 * (wave & 3), lds, c1, c2, lane, O2b, den2b);
    DBAR();
#pragma unroll
    for (int j = 0; j < 2; ++j) { const int tl = 32 * wave + 16 * j + l15;
#pragma unroll
        for (int dt = 0; dt < 4; ++dt) *(LAS f32x4*)(lds + L_ACC + tl * ACCSTR + (16 * dt + 4 * kg) * 4) = O1[j][dt];
        if (kg == 0) ((LAS float*)(lds + L_DEN))[tl] = den1[j]; }
    DBAR();
    { const int tl = ((16 * (wave & 3) + l15) << 2) + (wave >> 2);
#pragma unroll
      for (int dt = 0; dt < 4; ++dt) { LAS f32x4* ap = (LAS f32x4*)(lds + L_ACC + tl * ACCSTR + (16 * dt + 4 * kg) * 4); *ap = *ap + O2a[0][dt]; }
      if (kg == 0) { LAS float* dp = (LAS float*)(lds + L_DEN) + tl; *dp = *dp + den2a[0]; }
      const int tl2 = tl + 2;
#pragma unroll
      for (int dt = 0; dt < 4; ++dt) { LAS f32x4* ap = (LAS f32x4*)(lds + L_ACC + tl2 * ACCSTR + (16 * dt + 4 * kg) * 4); *ap = *ap + O2b[0][dt]; }
      if (kg == 0) { LAS float* dp = (LAS float*)(lds + L_DEN) + tl2; *dp = *dp + den2b[0]; } }
    DBAR();
    if (!(flags & 2)) { dtask<false, false>(Q, K, V, head, ss, g2, g3, ka, ka, lds, vst, c1, c2, lane);
    dtask<false, false>(Q, K, V, head, ss, g3, g3, ka, ka, lds, vst, c1, c2, lane); }
    DBAR();
    { const int tl = tid >> 1, d0 = (tid & 1) * 32; const float inv = 1.0f / ((LAS float*)(lds + L_DEN))[tl]; float s = 0.f; float o[32];
#pragma unroll
      for (int i = 0; i < 8; ++i) { const f32x4 a = *(LAS f32x4*)(lds + L_ACC + tl * ACCSTR + (d0 + 4 * i) * 4); o[4 * i] = a[0] * inv; o[4 * i + 1] = a[1] * inv; o[4 * i + 2] = a[2] * inv; o[4 * i + 3] = a[3] * inv; }
#pragma unroll
      for (int i = 0; i < 32; ++i) s += o[i] * o[i];
      s += __shfl_xor(s, 1); if ((tid & 1) == 0) unsafeAtomicAdd(ssq + tb + tl, s);
      bf16* op = MIX + (size_t)(tb + tl) * 1024 + 512 + head * 64 + d0;
#pragma unroll
      for (int i = 0; i < 4; ++i) { v4u w; w.x = pk2(o[8 * i], o[8 * i + 1]); w.y = pk2(o[8 * i + 2], o[8 * i + 3]); w.z = pk2(o[8 * i + 4], o[8 * i + 5]); w.w = pk2(o[8 * i + 6], o[8 * i + 7]); *(v4u*)(op + 8 * i) = w; } }
    DBAR();
}
__device__ __forceinline__ void phase_mixnorm(const Args& A, int tid) {
    bf16* MIX = (bf16*)(A.ws + 3 * SLOT); const float* sa = (const float*)(A.ws + OFF_SSQ) + (size_t)T * 6; const float* sb = sa + T;
    const int c8 = tid & 127, NB = gridDim.x;
    for (int r4 = blockIdx.x; r4 < T / 4; r4 += 4 * NB) {
        v4u q[4]; float rs[4];
#pragma unroll
        for (int i = 0; i < 4; ++i) { int rr = r4 + i * NB; rr = rr < T / 4 ? rr : T / 4 - 1; const int row = rr * 4 + (tid >> 7);
            q[i] = *(const v4u*)(MIX + (size_t)row * 1024 + c8 * 8); rs[i] = (c8 < 64 ? sa[row] : sb[row]); }
#pragma unroll
        for (int i = 0; i < 4; ++i) { int rr = r4 + i * NB; if (rr >= T / 4) continue; const int row = rr * 4 + (tid >> 7);
            const float s = 1.0f / sqrtf(rs[i] * (1.0f / 512.0f) + EPS); float x[8];
            x[0] = bflo(q[i].x) * s; x[1] = bfhi(q[i].x) * s; x[2] = bflo(q[i].y) * s; x[3] = bfhi(q[i].y) * s; x[4] = bflo(q[i].z) * s; x[5] = bfhi(q[i].z) * s; x[6] = bflo(q[i].w) * s; x[7] = bfhi(q[i].w) * s;
            store8(MIX + (size_t)row * 1024 + c8 * 8, x); }
    }
}
__device__ __forceinline__ void xattn_unit(const Args& A, LAS unsigned char* lds, int blk, int head, int tid, int lane, int wave) {
    constexpr int XS2 = 528;
    unsigned char* ws = A.ws; const int tb = blk * 128; const int sq = tb < TP ? (tb >> 13) : 2 + ((tb - TP) >> 12);
    const bf16* QX = (const bf16*)(ws + 5 * SLOT); const bf16* KX = (const bf16*)(ws + OFF_KX) + (size_t)sq * 256 * 1024 + head * 256;
    const bf16* VXT = (const bf16*)(ws + OFF_VXT) + (size_t)head * 256 * NMEM + sq * 256; bf16* XO = (bf16*)(ws + 3 * SLOT);
    const float* ssqq = (const float*)(ws + OFF_SSQ) + (size_t)T * 2;
#pragma unroll 4
    for (int i = 0; i < 16; ++i) { const int idx = tid + 512 * i, row = idx >> 5, ch = idx & 31; *(LAS v4u*)(lds + row * XS2 + ch * 16) = *(const v4u*)(KX + (size_t)row * 1024 + ch * 8); }
    float gm = 0.f;
#pragma unroll
    for (int i = 0; i < 4; ++i) gm = fmaxf(gm, fabsf(A.in[20][lane + 64 * i] * A.in[21][lane + 64 * i]));
    gm = wave_max(gm); const float c2 = 16.0f * gm * LOG2E;
    const int kg = lane >> 4, l15 = lane & 15;
    const int tok = tb + 16 * wave + l15;
    const float c1 = (1.0f / sqrtf(ssqq[(size_t)tok * 4 + head] * (1.0f / 256.0f) + EPS)) * (0.0625f * LOG2E);
    bf16x8 qf[8];
#pragma unroll
    for (int ks = 0; ks < 8; ++ks) qf[ks] = *(const bf16x8*)(QX + (size_t)tok * 1024 + head * 256 + 32 * ks + 8 * kg);
    LDSW(); __syncthreads();
    v4u pw[8]; float den = 0.f;
#pragma unroll
    for (int mt = 0; mt < 16; ++mt) {
        f32x4 st = (f32x4){0.f, 0.f, 0.f, 0.f};
#pragma unroll
        for (int ks = 0; ks < 8; ++ks) { const bf16x8 a = *(const LAS bf16x8*)(lds + (16 * mt + l15) * XS2 + (32 * ks + 8 * kg) * 2); st = MFMA16(a, qf[ks], st); }
        float p[4];
#pragma unroll
        for (int e = 0; e < 4; ++e) { p[e] = __builtin_amdgcn_exp2f(st[e] * c1 - c2); den += p[e]; }
        asm volatile("" ::: "memory");
        if (mt & 1) { pw[mt >> 1].z = pk2(p[0], p[1]); pw[mt >> 1].w = pk2(p[2], p[3]); } else { pw[mt >> 1].x = pk2(p[0], p[1]); pw[mt >> 1].y = pk2(p[2], p[3]); }
    }
    __syncthreads();
#pragma unroll 4
    for (int i = 0; i < 16; ++i) { const int idx = tid + 512 * i, row = idx >> 5, ch = idx & 31; *(LAS v4u*)(lds + row * XS2 + ch * 16) = *(const v4u*)(VXT + (size_t)row * NMEM + ch * 8); }
    den += __shfl_xor(den, 16); den += __shfl_xor(den, 32); const float inv = 1.0f / den;
    LDSW(); __syncthreads();
#pragma unroll 2
    for (int dt = 0; dt < 16; ++dt) {
        f32x4 O = (f32x4){0.f, 0.f, 0.f, 0.f};
#pragma unroll
        for (int c = 0; c < 8; ++c) { const LAS unsigned char* vp = lds + (16 * dt + l15) * XS2 + (32 * c + 4 * kg) * 2; const v2u a = *(const LAS v2u*)vp, b = *(const LAS v2u*)(vp + 32);
            const bf16x8 af = __builtin_bit_cast(bf16x8, ((v4u){a.x, a.y, b.x, b.y})); O = MFMA16(af, __builtin_bit_cast(bf16x8, pw[c]), O); }
        v2u w; w.x = pk2(O[0] * inv, O[1] * inv); w.y = pk2(O[2] * inv, O[3] * inv);
        *(v2u*)(XO + (size_t)tok * 1024 + head * 256 + 16 * dt + 4 * kg) = w;
    }
    __syncthreads();
}
#ifndef MK_ONE_LAUNCH
#define MK_ONE_LAUNCH 1
#endif
constexpr int NPHASE = 13;
__global__ void __launch_bounds__(512, 2) hymba_fwd(Args args) {
    extern __shared__ __attribute__((aligned(16))) unsigned char lds_raw[];
    LAS unsigned char* lds = (LAS unsigned char*)lds_raw;
    const int tid = threadIdx.x, lane = tid & 63, wave = __builtin_amdgcn_readfirstlane(tid >> 6);
    unsigned char* ws = args.ws; const int G = gridDim.x;
    const int lo = args.ph_lo, hi = args.ph_hi;
#define IN(k) (lo <= (k) && (k) < hi)
#define SEAM(k) do { if (IN(k) && IN((k) + 1)) xcd_barrier(bar); } while (0)
    using namespace pg8;
    if (tid < 16) ((LAS unsigned*)(lds + LDS_BYTES - 64))[tid] = 0u;
    __syncthreads();
    XcdBarrier bar = xcd_barrier_post((unsigned*)(ws + OFF_BAR), (volatile LAS unsigned*)(lds + LDS_BYTES - 64));
    float* ssq = (float*)(ws + OFF_SSQ);
    int vcu = (int)blockIdx.x, cxcd = (int)blockIdx.x;
    if (args.pad == 0x5a5a5a5a) cg::this_grid().sync();
    if (IN(0)) { phase_prologue(args, lds, tid, lane, wave); } SEAM(0);
    if (lo == 0 && hi > 1) {
        volatile LAS unsigned* stw = (volatile LAS unsigned*)(lds + LDS_BYTES - 64);
        if (tid == 0) { bool even = (G % 8) == 0; const unsigned per = (unsigned)(G / 8);
            for (unsigned j = 0; j < 16; ++j) { const unsigned cnt = xb_ld(&bar.bar[XB_XCNT(j)]); if (cnt != (j < 8 ? per : 0u)) even = false; }
            const unsigned rank = stw[4];
            if (even && bar.x < 8u && rank < per) { stw[5] = bar.x * per + rank; stw[6] = rank * 8u + bar.x; } else { stw[5] = blockIdx.x; stw[6] = blockIdx.x; } }
        __syncthreads();
        vcu = (int)stw[5]; cxcd = (int)stw[6];
    }
    if (IN(1)) {
        { Gemm g{(const bf16_t*)ws, (const bf16_t*)(ws + OFF_WIN), T, 3328, 1024}; StaticOrder S; S.init(T, 3328, G, cxcd);
          EpiG<1> E{(bf16_t*)(ws + 2 * SLOT), 512, nullptr, nullptr, nullptr, nullptr, nullptr, SLOT / 2, (float*)(ws + OFF_DT), nullptr};
          gemm_phase<EpiG<1>, StaticOrder, true, true>(lds, g, S, E); }
    } SEAM(1);
    if (IN(2)) { phase_elementwise(args, tid, lane); } SEAM(2);
    if (IN(3)) {
        for (int u = blockIdx.x; u < 768; u += G) ssd_states_unit(args, lds, u >> 1, u & 1, tid, lane, wave);
        if (!(args.flags & 1)) for (int v = vcu; v < 1536; v += G) dattn_unit(args, lds, v % 192, v / 192, tid, lane, wave, args.flags);
    } SEAM(3);
    if (IN(4)) {
        phase_scan(args, tid);
        { Gemm g{(const bf16_t*)(ws + OFF_MEMN), (const bf16_t*)(ws + OFF_WKV), NMEM, 1024, 1024}; StaticOrder S; S.init(NMEM, 1024, G, ((int)blockIdx.x + G - (192 % G)) % G);
          EpiG<0> E{(bf16_t*)(ws + OFF_KX), 1024, nullptr, nullptr, nullptr, nullptr, nullptr, 0, nullptr, nullptr};
          gemm_phase<EpiG<0>, StaticOrder, true, true>(lds, g, S, E); }
        { Gemm g{(const bf16_t*)(ws + OFF_WKV) + (size_t)1024 * 1024, (const bf16_t*)(ws + OFF_MEMN), 1024, NMEM, 1024}; StaticOrder S; S.init(1024, NMEM, G, ((int)blockIdx.x + G - (232 % G)) % G);
          EpiG<0> E{(bf16_t*)(ws + OFF_VXT), NMEM, nullptr, nullptr, nullptr, nullptr, nullptr, 0, nullptr, nullptr};
          gemm_phase<EpiG<0>, StaticOrder, true, true>(lds, g, S, E); }
    } SEAM(4);
    if (IN(5)) { for (int u = blockIdx.x; u < 768; u += G) ssd_out_unit(args, lds, u >> 1, u & 1, tid, lane, wave); } SEAM(5);
    if (IN(6)) { phase_mixnorm(args, tid); phase_kxnorm(args, tid); } SEAM(6);
    if (IN(7)) {
        Gemm g{(const bf16_t*)(ws + 3 * SLOT), (const bf16_t*)(ws + OFF_WOUT), T, 1024, 1024}; StaticOrder S; S.init(T, 1024, G, cxcd);
        EpiG<2> E{(bf16_t*)ws, 1024, nullptr, args.in[0], args.in[1], ssq, nullptr, 0, nullptr, nullptr};
        gemm_phase<EpiG<2>, StaticOrder, true, true>(lds, g, S, E);
    } SEAM(7);
    if (IN(8)) {
        Gemm g{(const bf16_t*)ws, (const bf16_t*)(ws + OFF_WQ), T, 1024, 1024}; StaticOrder S; S.init(T, 1024, G, cxcd);
        EpiG<3> E{(bf16_t*)(ws + 5 * SLOT), 1024, nullptr, nullptr, nullptr, ssq + (size_t)T * 2, ssq, 0, nullptr};
        gemm_phase<EpiG<3>, StaticOrder, true, true>(lds, g, S, E);
    } SEAM(8);
    if (IN(9)) { for (int v = vcu; v < 1536; v += G) xattn_unit(args, lds, v % 384, v / 384, tid, lane, wave); } SEAM(9);
    if (IN(10)) {
        Gemm g{(const bf16_t*)(ws + 3 * SLOT), (const bf16_t*)(ws + OFF_WO), T, 1024, 1024}; StaticOrder S; S.init(T, 1024, G, cxcd);
        EpiG<5> E{(bf16_t*)(ws + OFF_HB2), 1024, nullptr, nullptr, nullptr, ssq + T, nullptr, 0, nullptr, (const bf16_t*)ws};
        gemm_phase<EpiG<5>, StaticOrder, true, true>(lds, g, S, E);
    } SEAM(10);
    if (IN(11)) {
        Gemm g{(const bf16_t*)(ws + OFF_HB2), (const bf16_t*)(ws + OFF_W1), T, 4096, 1024}; StaticOrder S; S.init(T, 4096, G, cxcd);
        EpiG<6> E{(bf16_t*)ws, 4096, nullptr, nullptr, nullptr, nullptr, ssq + T, 0, nullptr};
        gemm_phase<EpiG<6>, StaticOrder, true, true>(lds, g, S, E);
    } SEAM(11);
    if (IN(12)) {
        Gemm g{(const bf16_t*)ws, (const bf16_t*)(ws + OFF_W2), T, 1024, 4096}; StaticOrder S; S.init(T, 1024, G, cxcd);
        EpiG<7> E{nullptr, 0, args.out, nullptr, nullptr, nullptr, nullptr, 0, nullptr, (const bf16_t*)(ws + OFF_HB2)};
        gemm_phase<EpiG<7>, StaticOrder, true, true>(lds, g, S, E);
    }
#undef IN
#undef SEAM
}

extern "C" void kernel_launch(void* const* d_in, const int* in_sizes, int n_in, void* d_out, int out_size, void* d_ws, size_t ws_size, hipStream_t stream) {
    static int grid = 0;
    if (grid == 0) {
        if (n_in != 26 || out_size != T * 1024 || ws_size < WS_NEED) { fprintf(stderr, "kernel_launch: unexpected shapes (n_in %d out %d ws %zu)\n", n_in, out_size, ws_size); grid = -1; return; }
        int dev = 0, cus = 0, per_cu = 0;
        (void)hipGetDevice(&dev); (void)hipDeviceGetAttribute(&cus, hipDeviceAttributeMultiprocessorCount, dev);
        if (hipFuncSetAttribute((const void*)hymba_fwd, hipFuncAttributeMaxDynamicSharedMemorySize, LDS_BYTES) != hipSuccess) { fprintf(stderr, "kernel_launch: hipFuncSetAttribute failed\n"); grid = -1; return; }
        (void)hipOccupancyMaxActiveBlocksPerMultiprocessor(&per_cu, (const void*)hymba_fwd, 512, LDS_BYTES);
        if (per_cu < 1) per_cu = 1;
        grid = cus * per_cu; (void)hipGetLastError();
    }
    if (grid < 0) return;
    (void)hipMemsetAsync((char*)d_ws + OFF_BAR, 0, 16384, stream);
    Args a{};
    for (int i = 0; i < 26; ++i) a.in[i] = (const float*)d_in[i];
    a.out = (float*)d_out; a.ws = (unsigned char*)d_ws;
#if MK_ONE_LAUNCH
    void* kargs[] = {&a};
#ifdef PROBE_K
    a.ph_lo = 0; a.ph_hi = PROBE_K + 1; a.flags = PROBE_FLAGS;
    (void)hipLaunchCooperativeKernel((const void*)hymba_fwd, dim3(grid), dim3(512), kargs, LDS_BYTES, stream);
    (void)hipMemsetAsync((char*)d_ws + OFF_BAR, 0, 16384, stream);
#endif
    a.ph_lo = 0; a.ph_hi = NPHASE; a.flags = 0;
    hipError_t e = hipLaunchCooperativeKernel((const void*)hymba_fwd, dim3(grid), dim3(512), kargs, LDS_BYTES, stream);
    if (e != hipSuccess) fprintf(stderr, "cooperative launch failed: %s (grid %d)\n", hipGetErrorString(e), grid);
#else
    for (int p = 0; p < NPHASE; ++p) { a.ph_lo = p; a.ph_hi = p + 1; hipLaunchKernelGGL(hymba_fwd, dim3(grid), dim3(512), LDS_BYTES, stream, a); }
#endif
}
```

```cpp
#include <hip/hip_runtime.h>
#include <hip/hip_cooperative_groups.h>
#include <cstdio>
#include <cstdint>
namespace cg = cooperative_groups;
namespace pg8 {
#define PG8_LAS __attribute__((address_space(3)))
typedef unsigned short bf16_t;
typedef short bf16x8 __attribute__((ext_vector_type(8)));
typedef float f32x4 __attribute__((ext_vector_type(4)));
typedef unsigned u32x4 __attribute__((ext_vector_type(4)));
constexpr int BM = 256, BK = 64, HALF = 128, HTB = HALF * BK * 2  , STAGE_BYTES = 8 * HTB, NXCD = 8, WGM = 8;

__host__ __device__ __forceinline__ int lds_byte(int r, int c) { const int st = (r >> 4) * 2 + (c >> 5), rr = r & 15, cc = c & 31, ob = rr * 64 + cc * 2; return st * 1024 + (ob ^ (((ob >> 9) & 1) << 5)); }
__host__ __device__ __forceinline__ void stage_rc(int b, int& R, int& C) { const int st = b / 1024, sb = b % 1024, swz = sb ^ (((sb >> 9) & 1) << 5); R = (st >> 1) * 16 + swz / 64; C = (st & 1) * 32 + (swz % 64) / 2; }
__host__ __device__ __forceinline__ int perm32(int rho) { const int n = rho >> 4, i = rho & 15; return 8 * (i >> 2) + 4 * n + (i & 3); }

struct Unit { int pm, pn; };
struct Gemm { const bf16_t* A; const bf16_t* Bt; int M, N, K; };

struct StaticOrder {
    int nM, nN, nwg, G, c;
    __host__ __device__ void init(int M, int N, int G_, int c_) { nM = M / BM; nN = N / BM; nwg = nM * nN; G = G_; c = c_; }
    __host__ __device__ bool next(int i, Unit& u) const {
        const long L = (long)i * G + c; if (L >= nwg) return false;
        int wgid = (int)L; { const int q = nwg / NXCD, r = nwg % NXCD, xcd = wgid % NXCD, off = wgid / NXCD; wgid = (xcd < r ? xcd * (q + 1) : r * (q + 1) + (xcd - r) * q) + off; }
        const int nig = WGM * nN, gid = wgid / nig, fm = gid * WGM, gsz = (nM - fm) < WGM ? (nM - fm) : WGM;
        u.pm = fm + ((wgid % nig) % gsz); u.pn = (wgid % nig) / gsz; return true;
    }
    __device__ __forceinline__ void a_ready(const Unit&) const {}
    __device__ __forceinline__ void done(const Unit&) const {}
};

__device__ __forceinline__ unsigned cvt_pk_bf16(float lo, float hi) { unsigned r; asm volatile("v_cvt_pk_bf16_f32 %0, %1, %2" : "=v"(r) : "v"(lo), "v"(hi)); return r; }
typedef float f32x2 __attribute__((ext_vector_type(2)));
template <class Epi, class Sched, bool ALIGN_EPI = false, bool SP2 = false>
__device__ __forceinline__ void gemm_phase(PG8_LAS unsigned char* lds, const Gemm g, const Sched& S, const Epi& E) {
    const int tid = threadIdx.x, wid = __builtin_amdgcn_readfirstlane(tid >> 6), lane = tid & 63, wr = wid >> 2, wc = wid & 3, fr = lane & 15, fq = lane >> 4;
    const int K = g.K, nt = K / BK;
    unsigned voffA[2], voffB[2];
#pragma unroll
    for (int i = 0; i < 2; ++i) { int R, C; stage_rc(tid * 16 + i * 8192, R, C); const int Rb = Epi::PERM ? ((R & ~31) + perm32(R & 31)) : R;
        voffA[i] = (unsigned)(R * K + C) * 2u; voffB[i] = (unsigned)(Rb * K + C) * 2u; }
    const size_t kstep = (size_t)(BK * 2);
    const size_t hstep = (size_t)HALF * K * 2;
    const size_t tstep = 2 * hstep;
    const unsigned ldsw = (unsigned)wid * 1024u;
    const int aoff = lds_byte(wr * 64 + fr, fq * 8), boff = lds_byte(wc * 32 + fr, fq * 8);
#define PG8_SA(b, h) (((b) * 2 + (h)) * HTB)
#define PG8_SB(b, h) ((4 + (b) * 2 + (h)) * HTB)
#define PG8_STAGE(bufoff, gbase, voff) do { _Pragma("unroll") for (int _i = 0; _i < 2; ++_i) \
        __builtin_amdgcn_global_load_lds((const unsigned*)((const char*)(gbase) + (voff)[_i]), (PG8_LAS unsigned*)(lds + (bufoff) + ldsw + _i * 8192), 16, 0, 0); } while (0)
#define PG8_LDA(dst, b, h) do { _Pragma("unroll") for (int m = 0; m < 4; ++m) _Pragma("unroll") for (int k = 0; k < 2; ++k) dst[m][k] = *(const PG8_LAS bf16x8*)(lds + PG8_SA(b, h) + aoff + m * 2048 + k * 1024); } while (0)
#define PG8_LDB(dst, b, h) do { _Pragma("unroll") for (int n = 0; n < 2; ++n) _Pragma("unroll") for (int k = 0; k < 2; ++k) dst[n][k] = *(const PG8_LAS bf16x8*)(lds + PG8_SB(b, h) + boff + n * 2048 + k * 1024); } while (0)
#define PG8_MMA(ai, bj, At, Bt) do { __builtin_amdgcn_s_setprio(1); _Pragma("unroll") for (int m = 0; m < 4; ++m) _Pragma("unroll") for (int n = 0; n < 2; ++n) _Pragma("unroll") for (int k = 0; k < 2; ++k) \
        acc[ai][bj][m][n] = __builtin_amdgcn_mfma_f32_16x16x32_bf16(Bt[n][k], At[m][k], acc[ai][bj][m][n], 0, 0, 0); __builtin_amdgcn_s_setprio(0); } while (0)
#define PG8_WAIT_V(n) asm volatile("s_waitcnt vmcnt(" #n ")" ::: "memory")
#define PG8_WAIT_L(n) asm volatile("s_waitcnt lgkmcnt(" #n ")" ::: "memory")
#define PG8_BAR __builtin_amdgcn_s_barrier()
#define PG8_SCHED __builtin_amdgcn_sched_barrier(0)
    Unit cur, nxt; int ui = 0;
    if (!S.next(0, cur)) return;
    f32x4 acc[2][2][4][2];
#pragma unroll
    for (int a = 0; a < 2; ++a)
#pragma unroll
        for (int b = 0; b < 2; ++b)
#pragma unroll
            for (int m = 0; m < 4; ++m)
#pragma unroll
                for (int n = 0; n < 2; ++n) acc[a][b][m][n] = (f32x4){0.f, 0.f, 0.f, 0.f};
    bf16x8 At[4][2], B0[2][2], B1[2][2];
    const char* cA = (const char*)g.A + (size_t)cur.pm * tstep; const char* cB = (const char*)g.Bt + (size_t)cur.pn * tstep;
    S.a_ready(cur);
    if constexpr (SP2) {
        PG8_STAGE(PG8_SB(0, 0), cB, voffB); PG8_STAGE(PG8_SB(0, 1), cB + hstep, voffB); PG8_STAGE(PG8_SA(0, 0), cA, voffA); PG8_STAGE(PG8_SA(0, 1), cA + hstep, voffA);
        if (wr == 1) PG8_BAR;
        PG8_WAIT_V(2); PG8_BAR;
        PG8_STAGE(PG8_SB(1, 0), cB + kstep, voffB); PG8_STAGE(PG8_SA(1, 0), cA + kstep, voffA); PG8_STAGE(PG8_SB(1, 1), cB + hstep + kstep, voffB);
        PG8_WAIT_V(6); PG8_BAR;
    } else {
        PG8_STAGE(PG8_SB(0, 0), cB, voffB); PG8_STAGE(PG8_SA(0, 0), cA, voffA); PG8_STAGE(PG8_SB(0, 1), cB + hstep, voffB); PG8_STAGE(PG8_SA(0, 1), cA + hstep, voffA);
        if (wr == 1) PG8_BAR;
        PG8_WAIT_V(4); PG8_BAR;
        PG8_STAGE(PG8_SB(1, 0), cB + kstep, voffB); PG8_STAGE(PG8_SA(1, 0), cA + kstep, voffA); PG8_STAGE(PG8_SB(1, 1), cB + hstep + kstep, voffB);
        PG8_WAIT_V(6); PG8_BAR;
    }
    for (;;) {
        const bool has_next = S.next(ui + 1, nxt);
        const char* nA = has_next ? (const char*)g.A + (size_t)nxt.pm * tstep : cA; const char* nB = has_next ? (const char*)g.Bt + (size_t)nxt.pn * tstep : cB;
        for (int t = 0; t < nt; t += 2) {
            const bool last = (t == nt - 2);
            const char* a1 = cA + (size_t)(t + 1) * kstep;
            const char* a2 = last ? nA : cA + (size_t)(t + 2) * kstep; const char* b2 = last ? nB : cB + (size_t)(t + 2) * kstep;
            const char* a3 = a2 + kstep; const char* b3 = b2 + kstep;
            if (last && has_next) S.a_ready(nxt);
            if constexpr (SP2) {
            PG8_LDB(B0, 0, 0); PG8_LDB(B1, 0, 1); PG8_SCHED; PG8_LDA(At, 0, 0); PG8_STAGE(PG8_SA(1, 1), a1 + hstep, voffA);
            PG8_WAIT_V(8); PG8_WAIT_L(0); PG8_BAR; PG8_MMA(0, 0, At, B0); PG8_MMA(0, 1, At, B1); PG8_BAR; PG8_SCHED;
            PG8_LDA(At, 0, 1); PG8_STAGE(PG8_SB(0, 0), b2, voffB); PG8_STAGE(PG8_SB(0, 1), b2 + hstep, voffB); PG8_STAGE(PG8_SA(0, 0), a2, voffA);
            PG8_WAIT_V(8); PG8_WAIT_L(0); PG8_BAR; PG8_MMA(1, 0, At, B0); PG8_MMA(1, 1, At, B1); PG8_BAR; PG8_SCHED;
            PG8_LDB(B0, 1, 0); PG8_LDB(B1, 1, 1); PG8_SCHED; PG8_LDA(At, 1, 0); PG8_STAGE(PG8_SA(0, 1), a2 + hstep, voffA);
            PG8_WAIT_V(8); PG8_WAIT_L(0); PG8_BAR; PG8_MMA(0, 0, At, B0); PG8_MMA(0, 1, At, B1); PG8_BAR; PG8_SCHED;
            PG8_LDA(At, 1, 1); PG8_STAGE(PG8_SB(1, 0), b3, voffB); PG8_STAGE(PG8_SB(1, 1), b3 + hstep, voffB); PG8_STAGE(PG8_SA(1, 0), a3, voffA);
            PG8_WAIT_V(8); PG8_WAIT_L(0); PG8_BAR; PG8_MMA(1, 0, At, B0); PG8_MMA(1, 1, At, B1); PG8_BAR; PG8_SCHED;
            } else {
            PG8_LDB(B0, 0, 0); PG8_SCHED; PG8_LDA(At, 0, 0); PG8_STAGE(PG8_SA(1, 1), a1 + hstep, voffA);
            PG8_WAIT_L(8); PG8_BAR; PG8_WAIT_L(0); PG8_MMA(0, 0, At, B0); PG8_BAR; PG8_SCHED;
            PG8_LDB(B1, 0, 1); PG8_STAGE(PG8_SB(0, 0), b2, voffB);
            PG8_BAR; PG8_WAIT_L(0); PG8_MMA(0, 1, At, B1); PG8_BAR;
            PG8_LDA(At, 0, 1); PG8_STAGE(PG8_SA(0, 0), a2, voffA);
            PG8_BAR; PG8_WAIT_L(0); PG8_MMA(1, 0, At, B0); PG8_BAR; PG8_SCHED;
            PG8_STAGE(PG8_SB(0, 1), b2 + hstep, voffB);
            PG8_WAIT_V(6); PG8_BAR; PG8_MMA(1, 1, At, B1); PG8_BAR;
            PG8_LDB(B0, 1, 0); PG8_SCHED; PG8_LDA(At, 1, 0); PG8_STAGE(PG8_SA(0, 1), a2 + hstep, voffA);
            PG8_WAIT_L(8); PG8_BAR; PG8_WAIT_L(0); PG8_MMA(0, 0, At, B0); PG8_BAR; PG8_SCHED;
            PG8_LDB(B1, 1, 1); PG8_STAGE(PG8_SB(1, 0), b3, voffB);
            PG8_BAR; PG8_WAIT_L(0); PG8_MMA(0, 1, At, B1); PG8_BAR;
            PG8_LDA(At, 1, 1); PG8_STAGE(PG8_SA(1, 0), a3, voffA);
            PG8_BAR; PG8_WAIT_L(0); PG8_MMA(1, 0, At, B0); PG8_BAR; PG8_SCHED;
            PG8_STAGE(PG8_SB(1, 1), b3 + hstep, voffB);
            PG8_WAIT_V(6); PG8_BAR; PG8_MMA(1, 1, At, B1); PG8_BAR;
            }
        }
        if constexpr (ALIGN_EPI) { if (wr == 0) PG8_BAR; }
        if constexpr (!Epi::AFTER_DRAIN) { E(acc, cur, wr, wc, fr, fq); S.done(cur); }
        if (!has_next) break;
#pragma unroll
        for (int a = 0; a < 2; ++a)
#pragma unroll
            for (int b = 0; b < 2; ++b)
#pragma unroll
                for (int m = 0; m < 4; ++m)
#pragma unroll
                    for (int n = 0; n < 2; ++n) acc[a][b][m][n] = (f32x4){0.f, 0.f, 0.f, 0.f};
        cur = nxt; cA = nA; cB = nB; ++ui;
        if constexpr (ALIGN_EPI) { if (wr == 1) PG8_BAR; }
    }
    PG8_WAIT_V(0);
    if constexpr (!ALIGN_EPI) { if (wr == 0) PG8_BAR; }
    PG8_BAR;
    if constexpr (Epi::AFTER_DRAIN) { E.fused(acc, cur, wr, wc, fr, fq, lds, wid, lane); S.done(cur); }
#undef PG8_SA
#undef PG8_SB
#undef PG8_STAGE
#undef PG8_LDA
#undef PG8_LDB
#undef PG8_MMA
#undef PG8_WAIT_V
#undef PG8_WAIT_L
#undef PG8_BAR
#undef PG8_SCHED
}
}
namespace pg8 {
constexpr int TPROMPT = 16384;
template <int MODE> struct EpiG {
    static constexpr bool PERM = true, AFTER_DRAIN = false;
    bf16_t* ob; int ldb; float* of; const float* r0; const float* r1; float* ssq; const float* rin; size_t split_stride; float* dt; const bf16_t* rb;
    __device__ __forceinline__ void operator()(const f32x4 (&acc)[2][2][4][2], const Unit& u, int wr, int wc, int fr, int fq) const {
        const int row0 = u.pm * BM + wr * 64 + fr; const int colt = u.pn * BM; const int cl = wc * 32 + 8 * fq;
        if (MODE == 2 || MODE == 5 || MODE == 7) {
            u32x4 rv[8][2]; float rsc[8];
            constexpr int AHEAD = 2;
#define EPI_LDRES(g_) do { const int nrow_ = row0 + ((g_) >> 2) * HALF + ((g_) & 3) * 16; \
                if (MODE == 2) rsc[g_] = rin[nrow_]; \
                { const bf16_t* rp_ = rb + (size_t)nrow_ * 1024 + colt + cl; \
                    _Pragma("unroll") for (int bj = 0; bj < 2; ++bj) rv[g_][bj] = *(const u32x4*)(rp_ + bj * HALF); } } while (0)
#pragma unroll
            for (int g = 0; g < AHEAD; ++g) EPI_LDRES(g);
#pragma unroll
            for (int g = 0; g < 8; ++g) {
                const int ai = g >> 2, m = g & 3; const int row = row0 + ai * HALF + m * 16;
                if (g + AHEAD < 8) EPI_LDRES(g + AHEAD);
                float s = 0.f;
#pragma unroll
                for (int bj = 0; bj < 2; ++bj) {
                    f32x4 v0 = acc[ai][bj][m][0], v1 = acc[ai][bj][m][1];
                    { const u32x4 rr = rv[g][bj]; const float sc = (MODE == 2) ? rsc[g] : 1.0f;
                        v0[0] += __uint_as_float(rr.x << 16) * sc; v0[1] += __uint_as_float(rr.x & 0xffff0000u) * sc; v0[2] += __uint_as_float(rr.y << 16) * sc; v0[3] += __uint_as_float(rr.y & 0xffff0000u) * sc;
                        v1[0] += __uint_as_float(rr.z << 16) * sc; v1[1] += __uint_as_float(rr.z & 0xffff0000u) * sc; v1[2] += __uint_as_float(rr.w << 16) * sc; v1[3] += __uint_as_float(rr.w & 0xffff0000u) * sc; }
                    if (MODE == 7) { float* op = of + (size_t)row * 1024 + colt + cl + bj * HALF; *(f32x4*)op = v0; *(f32x4*)(op + 4) = v1; }
                    else { u32x4 w; w.x = cvt_pk_bf16(v0[0], v0[1]); w.y = cvt_pk_bf16(v0[2], v0[3]); w.z = cvt_pk_bf16(v1[0], v1[1]); w.w = cvt_pk_bf16(v1[2], v1[3]);
                        *(u32x4*)(ob + (size_t)row * 1024 + colt + cl + bj * HALF) = w;
                        s += (v0[0] * v0[0] + v0[1] * v0[1]) + (v0[2] * v0[2] + v0[3] * v0[3]) + (v1[0] * v1[0] + v1[1] * v1[1]) + (v1[2] * v1[2] + v1[3] * v1[3]); }
                }
                if (MODE != 7) { s += __shfl_xor(s, 16); s += __shfl_xor(s, 32); if (fq == 0) unsafeAtomicAdd(ssq + row, s); }
            }
#undef EPI_LDRES
            return;
        }
        float rsv[2][4];
        if (MODE == 3 || MODE == 6) {
#pragma unroll
            for (int ai = 0; ai < 2; ++ai)
#pragma unroll
                for (int m = 0; m < 4; ++m) rsv[ai][m] = rin[row0 + ai * HALF + m * 16];
#pragma unroll
            for (int ai = 0; ai < 2; ++ai)
#pragma unroll
                for (int m = 0; m < 4; ++m) rsv[ai][m] = 1.0f / sqrtf(rsv[ai][m] * (1.0f / 1024.0f) + 1e-6f);
        }
#pragma unroll
        for (int ai = 0; ai < 2; ++ai)
#pragma unroll
            for (int m = 0; m < 4; ++m) {
                const int row = row0 + ai * HALF + m * 16;
                if (MODE == 0) {
#pragma unroll
                    for (int bj = 0; bj < 2; ++bj) { const f32x4 v0 = acc[ai][bj][m][0], v1 = acc[ai][bj][m][1]; u32x4 w; w.x = cvt_pk_bf16(v0[0], v0[1]); w.y = cvt_pk_bf16(v0[2], v0[3]); w.z = cvt_pk_bf16(v1[0], v1[1]); w.w = cvt_pk_bf16(v1[2], v1[3]);
                        *(u32x4*)(ob + (size_t)row * ldb + colt + cl + bj * HALF) = w; }
                } else if (MODE == 1) {
                    if (u.pn < 12) { bf16_t* base = ob + (size_t)(u.pn >> 1) * split_stride + (size_t)row * 512 + (u.pn & 1) * 256 + cl;
#pragma unroll
                        for (int bj = 0; bj < 2; ++bj) { const f32x4 v0 = acc[ai][bj][m][0], v1 = acc[ai][bj][m][1]; u32x4 w; w.x = cvt_pk_bf16(v0[0], v0[1]); w.y = cvt_pk_bf16(v0[2], v0[3]); w.z = cvt_pk_bf16(v1[0], v1[1]); w.w = cvt_pk_bf16(v1[2], v1[3]);
                            *(u32x4*)(base + bj * HALF) = w; }
                    } else if (wc == 0 && fq < 2) { float* p = dt + (size_t)row * 16 + 8 * fq; *(f32x4*)p = acc[ai][0][m][0]; *(f32x4*)(p + 4) = acc[ai][0][m][1]; }
                } else if (MODE == 2) {
                    const float* rp = (row < TPROMPT ? r0 + (size_t)row * 1024 : r1 + (size_t)(row - TPROMPT) * 1024) + colt + cl; float s = 0.f;
#pragma unroll
                    for (int bj = 0; bj < 2; ++bj) { const f32x4 v0 = acc[ai][bj][m][0] + *(const f32x4*)(rp + bj * HALF), v1 = acc[ai][bj][m][1] + *(const f32x4*)(rp + bj * HALF + 4);
                        u32x4 w; w.x = cvt_pk_bf16(v0[0], v0[1]); w.y = cvt_pk_bf16(v0[2], v0[3]); w.z = cvt_pk_bf16(v1[0], v1[1]); w.w = cvt_pk_bf16(v1[2], v1[3]);
                        *(u32x4*)(ob + (size_t)row * 1024 + colt + cl + bj * HALF) = w;
                        s += (v0[0] * v0[0] + v0[1] * v0[1]) + (v0[2] * v0[2] + v0[3] * v0[3]) + (v1[0] * v1[0] + v1[1] * v1[1]) + (v1[2] * v1[2] + v1[3] * v1[3]); }
                    s += __shfl_xor(s, 16); s += __shfl_xor(s, 32); if (fq == 0) unsafeAtomicAdd(ssq + row, s);
                } else if (MODE == 5 || MODE == 7) {
                    const bf16_t* rp = rb + (size_t)row * 1024 + colt + cl; float s = 0.f;
#pragma unroll
                    for (int bj = 0; bj < 2; ++bj) { const u32x4 rr = *(const u32x4*)(rp + bj * HALF);
                        f32x4 v0 = acc[ai][bj][m][0], v1 = acc[ai][bj][m][1];
                        v0[0] += __uint_as_float(rr.x << 16); v0[1] += __uint_as_float(rr.x & 0xffff0000u); v0[2] += __uint_as_float(rr.y << 16); v0[3] += __uint_as_float(rr.y & 0xffff0000u);
                        v1[0] += __uint_as_float(rr.z << 16); v1[1] += __uint_as_float(rr.z & 0xffff0000u); v1[2] += __uint_as_float(rr.w << 16); v1[3] += __uint_as_float(rr.w & 0xffff0000u);
                        if (MODE == 5) { u32x4 w; w.x = cvt_pk_bf16(v0[0], v0[1]); w.y = cvt_pk_bf16(v0[2], v0[3]); w.z = cvt_pk_bf16(v1[0], v1[1]); w.w = cvt_pk_bf16(v1[2], v1[3]);
                            *(u32x4*)(ob + (size_t)row * 1024 + colt + cl + bj * HALF) = w;
                            s += (v0[0] * v0[0] + v0[1] * v0[1]) + (v0[2] * v0[2] + v0[3] * v0[3]) + (v1[0] * v1[0] + v1[1] * v1[1]) + (v1[2] * v1[2] + v1[3] * v1[3]); }
                        else { float* op = of + (size_t)row * 1024 + colt + cl + bj * HALF; *(f32x4*)op = v0; *(f32x4*)(op + 4) = v1; } }
                    if (MODE == 5) { s += __shfl_xor(s, 16); s += __shfl_xor(s, 32); if (fq == 0) unsafeAtomicAdd(ssq + row, s); }
                } else if (MODE == 3 || MODE == 6) {
                    const float rs = rsv[ai][m]; float s = 0.f;
#pragma unroll
                    for (int bj = 0; bj < 2; ++bj) { f32x4 v0 = acc[ai][bj][m][0] * rs, v1 = acc[ai][bj][m][1] * rs;
                        if (MODE == 6) {
#pragma unroll
                            for (int e = 0; e < 4; ++e) { const float a = fmaxf(v0[e], 0.f), b = fmaxf(v1[e], 0.f); v0[e] = a * a; v1[e] = b * b; } }
                        u32x4 w; w.x = cvt_pk_bf16(v0[0], v0[1]); w.y = cvt_pk_bf16(v0[2], v0[3]); w.z = cvt_pk_bf16(v1[0], v1[1]); w.w = cvt_pk_bf16(v1[2], v1[3]);
                        *(u32x4*)(ob + (size_t)row * ldb + colt + cl + bj * HALF) = w;
                        if (MODE == 3) s += (v0[0] * v0[0] + v0[1] * v0[1]) + (v0[2] * v0[2] + v0[3] * v0[3]) + (v1[0] * v1[0] + v1[1] * v1[1]) + (v1[2] * v1[2] + v1[3] * v1[3]); }
                    if (MODE == 3) { s += __shfl_xor(s, 16); s += __shfl_xor(s, 32); if (fq == 0) unsafeAtomicAdd(ssq + (size_t)row * 4 + u.pn, s); }
                }
            }
    }
};
}
#define LAS __attribute__((address_space(3)))
typedef unsigned short bf16;
typedef unsigned v4u __attribute__((ext_vector_type(4)));
typedef unsigned v2u __attribute__((ext_vector_type(2)));
typedef float f32x4 __attribute__((ext_vector_type(4)));
typedef short bf16x8 __attribute__((ext_vector_type(8)));
typedef short v4i16_t __attribute__((ext_vector_type(4)));

constexpr int T = 49152, TP = 16384, DM = 1024, NMEM = 2560;
constexpr size_t MiB = 1u << 20;
constexpr size_t SLOT = (size_t)T * 512 * 2;
constexpr size_t OFF_WIN = 384 * MiB, OFF_MEMN = 392 * MiB, OFF_KX = 400 * MiB, OFF_VXT = 408 * MiB, OFF_DT = 416 * MiB, OFF_DEC = 420 * MiB;
constexpr size_t OFF_HB2 = 384 * MiB;
constexpr size_t OFF_W1 = 480 * MiB, OFF_W2 = 488 * MiB, OFF_WOUT = 496 * MiB, OFF_WQ = 498 * MiB, OFF_WKV = 500 * MiB, OFF_WO = 504 * MiB, OFF_SSQ = 506 * MiB;
constexpr size_t OFF_BAR = 509 * MiB, OFF_IRS = 508 * MiB;
constexpr size_t WS_NEED = 512 * MiB;
constexpr int LDS_BYTES = 147456;
constexpr float EPS = 1e-6f;
constexpr float LOG2E = 1.4426950408889634f;

struct Args { const float* in[26]; float* out; unsigned char* ws; int ph_lo, ph_hi, flags, pad; };

typedef float f32x2_t __attribute__((ext_vector_type(2))); typedef __bf16 bf16x2_t __attribute__((ext_vector_type(2)));
__device__ __forceinline__ unsigned pk2(float lo, float hi) { const f32x2_t v = {lo, hi}; const bf16x2_t b = __builtin_convertvector(v, bf16x2_t); return __builtin_bit_cast(unsigned, b); }
__device__ __forceinline__ unsigned f2bf(float f) { return pk2(f, 0.f) & 0xffffu; }
__device__ __forceinline__ float bflo(unsigned u) { return __uint_as_float(u << 16); }
__device__ __forceinline__ float bfhi(unsigned u) { return __uint_as_float(u & 0xffff0000u); }
__device__ __forceinline__ float bf1(bf16 b) { return __uint_as_float((unsigned)b << 16); }
__device__ __forceinline__ float wave_sum(float v) {
#pragma unroll
    for (int o = 1; o < 64; o <<= 1) v += __shfl_xor(v, o);
    return v; }
__device__ __forceinline__ float wave_max(float v) {
#pragma unroll
    for (int o = 1; o < 64; o <<= 1) v = fmaxf(v, __shfl_xor(v, o));
    return v; }
__device__ __forceinline__ void seq_of(int t, int& start, int& len) { if (t < TP) { start = t & ~8191; len = 8192; } else { start = TP + ((t - TP) & ~4095); len = 4096; } }
#define LDSW() asm volatile("s_waitcnt lgkmcnt(0)" ::: "memory")
#define MFMA16(a, b, c) __builtin_amdgcn_mfma_f32_16x16x32_bf16((a), (b), (c), 0, 0, 0)
__device__ __forceinline__ bf16x8 tr_frag(LAS unsigned char* img, int stride, int rowA, int rowB, int col0, int lane) {
    const int q = (lane & 15) >> 2, pp = lane & 3;
    const v4i16_t a = __builtin_amdgcn_ds_read_tr16_b64_v4i16((LAS v4i16_t*)(img + (rowA + q) * stride + (col0 + 4 * pp) * 2));
    const v4i16_t b = __builtin_amdgcn_ds_read_tr16_b64_v4i16((LAS v4i16_t*)(img + (rowB + q) * stride + (col0 + 4 * pp) * 2));
    return (bf16x8){a[0], a[1], a[2], a[3], b[0], b[1], b[2], b[3]};
}
__device__ __forceinline__ bf16x8 pack8(const f32x4& a, const f32x4& b) { v4u w; w.x = pk2(a[0], a[1]); w.y = pk2(a[2], a[3]); w.z = pk2(b[0], b[1]); w.w = pk2(b[2], b[3]); return __builtin_bit_cast(bf16x8, w); }

__device__ __forceinline__ void p0_transpose_item(const float* W, int ldw, int K, int ncols, bf16* WT, int row_off, const float* g0, const float* g1, LAS float* scr, int item, int lane) {
    const int nblk = ncols / 32, kb = item / nblk, nb = item % nblk, k0 = 64 * kb, n0 = 32 * nb;
#pragma unroll
    for (int i = 0; i < 8; ++i) { const int kk = 8 * i + (lane >> 3), nq = (lane & 7) * 4; const int k = k0 + kk; const float gg = g0 ? (k < 512 ? g0[k] : g1[k - 512]) : 1.0f;
        const f32x4 v = *(const f32x4*)(W + (size_t)k * ldw + n0 + nq);
        scr[kk * 33 + nq] = v[0] * gg; scr[kk * 33 + nq + 1] = v[1] * gg; scr[kk * 33 + nq + 2] = v[2] * gg; scr[kk * 33 + nq + 3] = v[3] * gg; }
    LDSW();
    const int c = lane & 7;
#pragma unroll
    for (int j = 0; j < 4; ++j) { const int n = (lane >> 3) + 8 * j; const LAS float* s = scr + (8 * c) * 33 + n;
        v4u o; o.x = pk2(s[0 * 33], s[1 * 33]); o.y = pk2(s[2 * 33], s[3 * 33]); o.z = pk2(s[4 * 33], s[5 * 33]); o.w = pk2(s[6 * 33], s[7 * 33]);
        *(v4u*)(WT + (size_t)(row_off + n0 + n) * K + k0 + 8 * c) = o; }
    LDSW();
}
template <int NR> __device__ __forceinline__ void rms_rows_to_bf16(const float* const (&xrow)[NR], const f32x4 (&g)[4], bf16* const (&orow)[NR], int lane, float* const (&irs)[NR]) {
    f32x4 v[NR][4];
#pragma unroll
    for (int r = 0; r < NR; ++r)
#pragma unroll
        for (int j = 0; j < 4; ++j) v[r][j] = ((const f32x4*)xrow[r])[lane + 64 * j];
#pragma unroll
    for (int r = 0; r < NR; ++r) { float s = 0.f;
#pragma unroll
        for (int j = 0; j < 4; ++j) s += (v[r][j].x * v[r][j].x + v[r][j].y * v[r][j].y) + (v[r][j].z * v[r][j].z + v[r][j].w * v[r][j].w);
        const float sd = sqrtf(wave_sum(s) * (1.0f / 1024.0f) + EPS); const float rs = 1.0f / sd; if (irs[r] && lane == 0) *irs[r] = sd;
        unsigned long long* o8 = (unsigned long long*)orow[r] + lane;
#pragma unroll
        for (int j = 0; j < 4; ++j) o8[64 * j] = (unsigned long long)pk2(v[r][j].x * rs * g[j].x, v[r][j].y * rs * g[j].y) | ((unsigned long long)pk2(v[r][j].z * rs * g[j].z, v[r][j].w * rs * g[j].w) << 32); }
}
__device__ __forceinline__ void phase_prologue(const Args& A, LAS unsigned char* lds, int tid, int lane, int wave) {
    unsigned char* ws = A.ws;
    LAS float* scr = (LAS float*)(lds + wave * 16384);
    const int G = gridDim.x, gw = blockIdx.x * 8 + wave, NGW = G * 8;
    bf16* Win_t = (bf16*)(ws + OFF_WIN);
    for (int it = gw; it < 8192; it += NGW) {
        int r = it;
        if (r < 768) { p0_transpose_item(A.in[5], 3088, 1024, 1536, Win_t, 0, A.in[4], A.in[4] + 512, scr, r, lane); continue; } r -= 768;
        if (r < 768) { p0_transpose_item(A.in[5] + 1552, 3088, 1024, 1536, Win_t, 1536, A.in[4], A.in[4] + 512, scr, r, lane); continue; } r -= 768;
        if (r < 512) { p0_transpose_item(A.in[15], 1024, 1024, 1024, (bf16*)(ws + OFF_WOUT), 0, A.in[11], A.in[14], scr, r, lane); continue; } r -= 512;
        if (r < 512) { p0_transpose_item(A.in[18], 1024, 1024, 1024, (bf16*)(ws + OFF_WQ), 0, A.in[16], A.in[16] + 512, scr, r, lane); continue; } r -= 512;
        if (r < 1024) { p0_transpose_item(A.in[19], 2048, 1024, 2048, (bf16*)(ws + OFF_WKV), 0, nullptr, nullptr, scr, r, lane); continue; } r -= 1024;
        if (r < 512) { p0_transpose_item(A.in[22], 1024, 1024, 1024, (bf16*)(ws + OFF_WO), 0, nullptr, nullptr, scr, r, lane); continue; } r -= 512;
        if (r < 2048) { p0_transpose_item(A.in[24], 4096, 1024, 4096, (bf16*)(ws + OFF_W1), 0, A.in[23], A.in[23] + 512, scr, r, lane); continue; } r -= 2048;
        p0_transpose_item(A.in[25], 1024, 4096, 1024, (bf16*)(ws + OFF_W2), 0, nullptr, nullptr, scr, r, lane);
    }
    const int gt = blockIdx.x * 512 + tid, NGT = G * 512;
    for (int i = gt; i < 16 * 1024; i += NGT) { const int n = i >> 10, k = i & 1023; Win_t[(size_t)(3072 + n) * 1024 + k] = (bf16)f2bf(A.in[5][(size_t)k * 3088 + 1536 + n] * A.in[4][k]); }
    for (int i = gt; i < 240 * 1024 / 8; i += NGT) ((v4u*)(Win_t + (size_t)3088 * 1024))[i] = (v4u){0u, 0u, 0u, 0u};
    { f32x4* z = (f32x4*)(ws + OFF_SSQ); for (int i = gt; i < T * 8 / 4; i += NGT) z[i] = (f32x4){0.f, 0.f, 0.f, 0.f}; }
    { f32x4 g[4];
#pragma unroll
      for (int j = 0; j < 4; ++j) g[j] = (f32x4){1.f, 1.f, 1.f, 1.f};
      bf16* XN = (bf16*)ws;
      for (int m = gw; m < T; m += 4 * NGW) { const float* xr[4]; bf16* orow[4]; float* irsp[4];
#pragma unroll
          for (int r = 0; r < 4; ++r) { int mm = m + r * NGW; mm = mm < T ? mm : T - 1; xr[r] = mm < TP ? A.in[0] + (size_t)mm * 1024 : A.in[1] + (size_t)(mm - TP) * 1024; orow[r] = XN + (size_t)mm * 1024; irsp[r] = (float*)(ws + OFF_IRS) + mm; }
          rms_rows_to_bf16<4>(xr, g, orow, lane, irsp); } }
    { f32x4 g[4];
#pragma unroll
      for (int j = 0; j < 4; ++j) g[j] = ((const f32x4*)A.in[17])[lane + 64 * j];
      bf16* MEMN = (bf16*)(ws + OFF_MEMN);
      for (int m = gw; m < NMEM; m += NGW) { const float* xr[1] = {m < 512 ? A.in[2] + (size_t)m * 1024 : A.in[3] + (size_t)(m - 512) * 1024}; bf16* orow[1] = {MEMN + (size_t)m * 1024}; float* irsn[1] = {nullptr}; rms_rows_to_bf16<1>(xr, g, orow, lane, irsn); } }
}

__device__ __forceinline__ void load8(const bf16* p, float (&v)[8]) { const v4u u = *(const v4u*)p; v[0] = bflo(u.x); v[1] = bfhi(u.x); v[2] = bflo(u.y); v[3] = bfhi(u.y); v[4] = bflo(u.z); v[5] = bfhi(u.z); v[6] = bflo(u.w); v[7] = bfhi(u.w); }
__device__ __forceinline__ void store8(bf16* p, const float (&v)[8]) { v4u u; u.x = pk2(v[0], v[1]); u.y = pk2(v[2], v[3]); u.z = pk2(v[4], v[5]); u.w = pk2(v[6], v[7]); *(v4u*)p = u; }
__device__ __forceinline__ void phase_elementwise(const Args& A, int tid, int lane) {
    unsigned char* ws = A.ws;
    for (int u = blockIdx.x; u < 1536; u += gridDim.x) {
        if (u < 768) {
            const int ten = u / 384, blk = u % 384, t0 = blk * 128; int ss, L; seq_of(t0, ss, L);
            const bf16* src = (const bf16*)(ws + (3 + ten) * SLOT); bf16* dst = (bf16*)((unsigned char*)A.out + (2 + ten) * SLOT);
            const int cgp = tid & 63, tg = tid >> 6, ch = ten * 512 + cgp * 8;
            float w[5][8], b[8];
#pragma unroll
            for (int k = 0; k < 5; ++k)
#pragma unroll
                for (int e = 0; e < 8; ++e) w[k][e] = A.in[6][k * 1024 + ch + e];
#pragma unroll
            for (int e = 0; e < 8; ++e) b[e] = A.in[7][ch + e];
            const int tb = t0 + tg * 16;
            v4u raw[20];
#pragma unroll
            for (int k = 0; k < 20; ++k) { const int tt = tb - 2 + k; raw[k] = (tt >= ss && tt < ss + L) ? *(const v4u*)(src + (size_t)tt * 512 + cgp * 8) : (v4u){0u, 0u, 0u, 0u}; }
#pragma unroll
            for (int i = 0; i < 16; ++i) {
                float o[8];
#pragma unroll
                for (int e = 0; e < 8; ++e) o[e] = b[e];
#pragma unroll
                for (int k = 0; k < 5; ++k) { const v4u q = raw[i + k];
                    o[0] += w[k][0] * bflo(q.x); o[1] += w[k][1] * bfhi(q.x); o[2] += w[k][2] * bflo(q.y); o[3] += w[k][3] * bfhi(q.y);
                    o[4] += w[k][4] * bflo(q.z); o[5] += w[k][5] * bfhi(q.z); o[6] += w[k][6] * bflo(q.w); o[7] += w[k][7] * bfhi(q.w); }
#pragma unroll
                for (int e = 0; e < 8; ++e) o[e] = o[e] * __builtin_amdgcn_rcpf(1.0f + __expf(-o[e]));
                store8(dst + (size_t)(tb + i) * 512 + cgp * 8, o);
            }
        } else {
            const int v = u - 768, ten = v / 384, blk = v % 384, t0 = blk * 128; int ss, L; seq_of(t0, ss, L);
            bf16* X = (bf16*)(ws + (5 + ten) * SLOT); const float* gp = A.in[12 + ten];
            const int c8 = tid & 63, sub = c8 & 7; float g[8];
#pragma unroll
            for (int e = 0; e < 8; ++e) g[e] = gp[sub * 8 + e];
            const float invf1 = exp2f(-(float)sub * 0.125f * 18.931568569324174f);
            v4u rq[16];
#pragma unroll
            for (int it = 0; it < 16; ++it) rq[it] = *(const v4u*)(X + (size_t)(t0 + it * 8 + (tid >> 6)) * 512 + c8 * 8);
#pragma unroll
            for (int it = 0; it < 16; ++it) {
                const int tok = t0 + it * 8 + (tid >> 6); bf16* p = X + (size_t)tok * 512 + c8 * 8; float x[8];
                { const v4u q = rq[it]; x[0] = bflo(q.x); x[1] = bfhi(q.x); x[2] = bflo(q.y); x[3] = bfhi(q.y); x[4] = bflo(q.z); x[5] = bfhi(q.z); x[6] = bflo(q.w); x[7] = bfhi(q.w); }
                float s = 0.f;
#pragma unroll
                for (int e = 0; e < 8; ++e) s += x[e] * x[e];
                s += __shfl_xor(s, 1); s += __shfl_xor(s, 2); s += __shfl_xor(s, 4);
                const float rs = 1.0f / sqrtf(s * (1.0f / 64.0f) + EPS);
#pragma unroll
                for (int e = 0; e < 8; ++e) x[e] = x[e] * rs * g[e];
                float o[8]; const float pos = (float)(tok - ss);
                float sn1, cs1;
                { const float ang = pos * invf1; const double rev = (double)ang * 0.15915494309189535; const float fr = (float)(rev - rint(rev)); sn1 = __builtin_amdgcn_sinf(fr); cs1 = __builtin_amdgcn_cosf(fr); }
#pragma unroll
                for (int e = 0; e < 8; ++e) { const float other = __shfl_xor(x[e], 1); const float sn = __shfl(sn1, (lane & ~7) + e), cs = __shfl(cs1, (lane & ~7) + e);
                    o[e] = sub == 0 ? x[e] * cs - other * sn : (sub == 1 ? x[e] * cs + other * sn : x[e]); }
                store8(p, o);
            }
        }
    }
}
__device__ __forceinline__ void phase_kxnorm(const Args& A, int tid) {
    unsigned char* ws = A.ws;
    for (int u = blockIdx.x; u < 640; u += gridDim.x) {
        {
            const int v = u; const int item = v * 16 + (tid >> 5), l5 = tid & 31; const int row = item >> 2, hd = item & 3;
            bf16* p = (bf16*)(ws + OFF_KX) + (size_t)row * 1024 + hd * 256 + l5 * 8; float x[8]; load8(p, x);
            float s = 0.f;
#pragma unroll
            for (int e = 0; e < 8; ++e) s += x[e] * x[e];
            s += __shfl_xor(s, 1); s += __shfl_xor(s, 2); s += __shfl_xor(s, 4); s += __shfl_xor(s, 8); s += __shfl_xor(s, 16);
            const float rs = 1.0f / sqrtf(s * (1.0f / 256.0f) + EPS);
#pragma unroll
            for (int e = 0; e < 8; ++e) x[e] = x[e] * rs * A.in[21][l5 * 8 + e] * A.in[20][l5 * 8 + e];
            store8(p, x);
        }
    }
}
#define XB_TMO      128
#define XB_XCNT(j)  (256  + 64 * (j))
#define XB_XSUB(j)  (1280 + 64 * (j))
#define XB_XGEN(j)  (2304 + 64 * (j))
#define XB_TOP      3328
#define XB_TOPGEN   3392
#define XCD_BAR_WORDS 3456
#define XB_SPIN_CAP (1u << 18)

__device__ __forceinline__ unsigned xb_ld(unsigned* p)              { return __hip_atomic_load(p, __ATOMIC_RELAXED, __HIP_MEMORY_SCOPE_AGENT); }
__device__ __forceinline__ unsigned xb_add(unsigned* p, unsigned v) { return __hip_atomic_fetch_add(p, v, __ATOMIC_RELAXED, __HIP_MEMORY_SCOPE_AGENT); }
__device__ __forceinline__ unsigned xb_xcc_id() { return (unsigned)__builtin_amdgcn_s_getreg((3 << 11) | 20) & 0xFu; }
#define XB_SPIN(cond, bar) do { unsigned _sp = 0; while (cond) { __builtin_amdgcn_s_sleep(1); \
    if ((++_sp & 255u) == 0u) { if (xb_ld(&(bar)[XB_TMO])) break; if (_sp > XB_SPIN_CAP) { atomicAdd(&(bar)[XB_TMO], 1u); break; } } } } while (0)

struct XcdBarrier {
    unsigned* bar; unsigned x;
    volatile LAS unsigned* st;
};

__device__ __forceinline__ XcdBarrier xcd_barrier_post(unsigned* bar, volatile LAS unsigned* st) {
    XcdBarrier b; b.bar = bar; b.x = xb_xcc_id(); b.st = st;
    if (threadIdx.x == 0) st[4] = xb_add(&bar[XB_XCNT(b.x)], 1u);
    return b;
}
__device__ __forceinline__ void xcd_barrier_complete(unsigned* bar, unsigned x, unsigned& nloc, unsigned& nx) {
    const unsigned G = gridDim.x * gridDim.y * gridDim.z;
    unsigned sum, cnt, mine, sp = 0u;
    for (;;) {
        sum = 0u; cnt = 0u; mine = 0u;
#pragma unroll
        for (unsigned j = 0; j < 16; ++j) { const unsigned c = xb_ld(&bar[XB_XCNT(j)]); sum += c; cnt += (c > 0u) ? 1u : 0u; mine = (j == x) ? c : mine; }
        if (sum == G) break;
        __builtin_amdgcn_s_sleep(1);
        if ((++sp & 255u) == 0u) { if (xb_ld(&bar[XB_TMO])) break; if (sp > XB_SPIN_CAP) { atomicAdd(&bar[XB_TMO], 1u); break; } }
    }
    nloc = mine > 0u ? mine : 1u; nx = cnt > 0u ? cnt : 1u;
}

__device__ __forceinline__ void xcd_barrier(const XcdBarrier& b) {
    asm volatile("s_waitcnt vmcnt(0)" ::: "memory");
    __syncthreads();
    if (threadIdx.x == 0) {
        unsigned* bar = b.bar;
        __builtin_amdgcn_s_waitcnt(0);
        unsigned nloc = b.st[0], nx = b.st[1];
        if (nloc == 0u) { xcd_barrier_complete(bar, b.x, nloc, nx); b.st[0] = nloc; b.st[1] = nx; }
        const unsigned old = xb_add(&bar[XB_XSUB(b.x)], 1u);
        const unsigned gen = old / nloc;
        if (old + 1u == (gen + 1u) * nloc) {
            __builtin_amdgcn_fence(__ATOMIC_RELEASE, "agent");
            asm volatile("s_waitcnt vmcnt(0)" ::: "memory");
            const unsigned og = xb_add(&bar[XB_TOP], 1u);
            const unsigned tg = og / nx;
            if (og + 1u == (tg + 1u) * nx) xb_add(&bar[XB_TOPGEN], 1u);
            else XB_SPIN(xb_ld(&bar[XB_TOPGEN]) == tg, bar);
            __builtin_amdgcn_fence(__ATOMIC_ACQUIRE, "agent");
            xb_add(&bar[XB_XGEN(b.x)], 1u);
            asm volatile("s_waitcnt vmcnt(0)" ::: "memory");
        } else {
            XB_SPIN(xb_ld(&bar[XB_XGEN(b.x)]) == gen, bar);
            __builtin_amdgcn_fence(__ATOMIC_ACQUIRE, "agent");
            asm volatile("s_waitcnt vmcnt(0)" ::: "memory");
        }
    }
    __syncthreads();
}
constexpr int L_VDT = 0, L_VCUM = 4096, L_VTOT = 8192, L_BIMG = 9216, BSTR = 272, XSTR = 144;
constexpr int L_XF = L_BIMG + 128 * BSTR  , L_XB = L_XF + 128 * XSTR  ;
constexpr int L_CIMG = L_BIMG + 128 * BSTR  , L_XIMG = L_CIMG + 128 * BSTR  , L_PIMG = L_XIMG + 128 * XSTR  ;
__device__ __forceinline__ void ssd_vectors(const Args& A, LAS unsigned char* lds, int t0, int g, int wave, int lane) {
    const int hh = wave >> 1, dir = wave & 1, head = 4 * g + hh;
    const float* DT = (const float*)(A.ws + OFF_DT);
    const float bias = A.in[9][dir * 8 + head], Aneg = -__expf(A.in[8][dir * 8 + head]);
    float d[2], a[2];
#pragma unroll
    for (int k = 0; k < 2; ++k) { const float x = DT[(size_t)(t0 + 2 * lane + k) * 16 + dir * 8 + head] + bias; d[k] = x > 20.f ? x : log1pf(__expf(x)); a[k] = d[k] * Aneg; }
    const float ps = a[0] + a[1]; float inc = ps;
#pragma unroll
    for (int o = 1; o < 64; o <<= 1) { const float y = __shfl_up(inc, o); if (lane >= o) inc += y; }
    const float exc = inc - ps; const float tot = __shfl(inc, 63);
    LAS float* vdt = (LAS float*)(lds + L_VDT) + (hh * 2 + dir) * 128; LAS float* vc = (LAS float*)(lds + L_VCUM) + (hh * 2 + dir) * 128;
    vdt[2 * lane] = d[0]; vdt[2 * lane + 1] = d[1];
    if (dir == 0) { vc[2 * lane] = exc + a[0]; vc[2 * lane + 1] = inc; } else { vc[2 * lane] = exc; vc[2 * lane + 1] = exc + a[0]; }
    if (lane == 0) ((LAS float*)(lds + L_VTOT))[hh * 2 + dir] = tot;
}
__device__ __forceinline__ void stage_rows128(const bf16* src, int ld, LAS unsigned char* img, int tid) {
#pragma unroll
    for (int i = 0; i < 4; ++i) { const int idx = tid + 512 * i, row = idx >> 4, ch = idx & 15; *(LAS v4u*)(img + row * BSTR + ch * 16) = *(const v4u*)(src + (size_t)row * ld + ch * 8); }
}
__device__ __forceinline__ void ssd_states_unit(const Args& A, LAS unsigned char* lds, int c, int g, int tid, int lane, int wave) {
    unsigned char* ws = A.ws; const int t0 = c * 128;
    const bf16* XS = (const bf16*)((const unsigned char*)A.out + 2 * SLOT); const bf16* BC = (const bf16*)((const unsigned char*)A.out + 3 * SLOT); bf16* ST = (bf16*)A.out;
    v4u xall[4][2];
#pragma unroll
    for (int hh = 0; hh < 4; ++hh)
#pragma unroll
        for (int h2 = 0; h2 < 2; ++h2) xall[hh][h2] = *(const v4u*)(XS + (size_t)(t0 + (tid >> 2)) * 512 + (4 * g + hh) * 64 + (tid & 3) * 16 + 8 * h2);
    ssd_vectors(A, lds, t0, g, wave, lane);
    stage_rows128(BC + (size_t)t0 * 512 + g * 128, 512, lds + L_BIMG, tid);
    LDSW(); __syncthreads();
    if (tid < 8) ((float*)(ws + OFF_DEC))[(c * 8 + 4 * g + (tid >> 1)) * 2 + (tid & 1)] = __expf(((LAS float*)(lds + L_VTOT))[tid]);
    const int kg = lane >> 4;
#pragma unroll
    for (int hh = 0; hh < 4; ++hh) {
        const int head = 4 * g + hh;
        { const int j = tid >> 2, c0 = (tid & 3) * 16; const LAS float* vdt = (LAS float*)(lds + L_VDT) + hh * 256; const LAS float* vc = (LAS float*)(lds + L_VCUM) + hh * 256;
          const float wf = __expf(fminf(((LAS float*)(lds + L_VTOT))[hh * 2] - vc[j], 0.f)) * vdt[j], wb = __expf(fminf(vc[128 + j], 0.f)) * vdt[128 + j];
#pragma unroll
          for (int h2 = 0; h2 < 2; ++h2) { float x[8]; { const v4u q = xall[hh][h2]; x[0] = bflo(q.x); x[1] = bfhi(q.x); x[2] = bflo(q.y); x[3] = bfhi(q.y); x[4] = bflo(q.z); x[5] = bfhi(q.z); x[6] = bflo(q.w); x[7] = bfhi(q.w); } v4u f, b;
              f.x = pk2(x[0] * wf, x[1] * wf); f.y = pk2(x[2] * wf, x[3] * wf); f.z = pk2(x[4] * wf, x[5] * wf); f.w = pk2(x[6] * wf, x[7] * wf);
              b.x = pk2(x[0] * wb, x[1] * wb); b.y = pk2(x[2] * wb, x[3] * wb); b.z = pk2(x[4] * wb, x[5] * wb); b.w = pk2(x[6] * wb, x[7] * wb);
              *(LAS v4u*)(lds + L_XF + j * XSTR + (c0 + 8 * h2) * 2) = f; *(LAS v4u*)(lds + L_XB + j * XSTR + (c0 + 8 * h2) * 2) = b; } }
        LDSW(); __syncthreads();
        const int dir = wave >> 2, nt0 = (wave & 3) * 2; LAS unsigned char* ximg = lds + (dir ? L_XB : L_XF);
        f32x4 acc[4][2];
#pragma unroll
        for (int pt = 0; pt < 4; ++pt)
#pragma unroll
            for (int nt = 0; nt < 2; ++nt) acc[pt][nt] = (f32x4){0.f, 0.f, 0.f, 0.f};
#pragma unroll
        for (int ks = 0; ks < 4; ++ks) {
            bf16x8 af[4], bfr[2]; const int r0 = 32 * ks + 8 * kg;
#pragma unroll
            for (int pt = 0; pt < 4; ++pt) af[pt] = tr_frag(ximg, XSTR, r0, r0 + 4, 16 * pt, lane);
#pragma unroll
            for (int nt = 0; nt < 2; ++nt) bfr[nt] = tr_frag(lds + L_BIMG, BSTR, r0, r0 + 4, 16 * (nt0 + nt), lane);
#pragma unroll
            for (int pt = 0; pt < 4; ++pt)
#pragma unroll
                for (int nt = 0; nt < 2; ++nt) acc[pt][nt] = MFMA16(af[pt], bfr[nt], acc[pt][nt]);
        }
        bf16* sp = ST + (size_t)((c * 8 + head) * 2 + dir) * 8192;
#pragma unroll
        for (int pt = 0; pt < 4; ++pt)
#pragma unroll
            for (int nt = 0; nt < 2; ++nt)
#pragma unroll
                for (int e = 0; e < 4; ++e) sp[(16 * pt + 4 * kg + e) * 128 + 16 * (nt0 + nt) + (lane & 15)] = (bf16)f2bf(acc[pt][nt][e]);
        LDSW(); __syncthreads();
    }
}
template <int NV> __device__ __forceinline__ void scan_task(bf16* ST, const float* DEC, int c0, int nc, int head, int dir, int eoff) {
    float carry[8 * NV];
#pragma unroll
    for (int e = 0; e < 8 * NV; ++e) carry[e] = 0.f;
    for (int k = 0; k < nc; k += 8) {
        v4u sv[8][NV]; float dc[8];
#pragma unroll
        for (int u = 0; u < 8; ++u) { const int c = dir ? c0 + nc - 1 - (k + u) : c0 + k + u; const bf16* p = ST + (size_t)((c * 8 + head) * 2 + dir) * 8192 + eoff;
#pragma unroll
            for (int h = 0; h < NV; ++h) sv[u][h] = *(const v4u*)(p + 8 * h);
            dc[u] = DEC[(c * 8 + head) * 2 + dir]; }
#pragma unroll
        for (int u = 0; u < 8; ++u) { const int c = dir ? c0 + nc - 1 - (k + u) : c0 + k + u; bf16* p = ST + (size_t)((c * 8 + head) * 2 + dir) * 8192 + eoff;
#pragma unroll
            for (int h = 0; h < NV; ++h) { v4u o; o.x = pk2(carry[8 * h], carry[8 * h + 1]); o.y = pk2(carry[8 * h + 2], carry[8 * h + 3]); o.z = pk2(carry[8 * h + 4], carry[8 * h + 5]); o.w = pk2(carry[8 * h + 6], carry[8 * h + 7]); *(v4u*)(p + 8 * h) = o;
                const v4u s_ = sv[u][h]; const float d = dc[u];
                carry[8 * h] = carry[8 * h] * d + bflo(s_.x); carry[8 * h + 1] = carry[8 * h + 1] * d + bfhi(s_.x); carry[8 * h + 2] = carry[8 * h + 2] * d + bflo(s_.y); carry[8 * h + 3] = carry[8 * h + 3] * d + bfhi(s_.y);
                carry[8 * h + 4] = carry[8 * h + 4] * d + bflo(s_.z); carry[8 * h + 5] = carry[8 * h + 5] * d + bfhi(s_.z); carry[8 * h + 6] = carry[8 * h + 6] * d + bflo(s_.w); carry[8 * h + 7] = carry[8 * h + 7] * d + bfhi(s_.w); } }
    }
}
__device__ __forceinline__ void phase_scan(const Args& A, int tid) {
    bf16* ST = (bf16*)A.out; const float* DEC = (const float*)(A.ws + OFF_DEC);
    for (int idx = blockIdx.x * 512 + tid; idx < 98304; idx += gridDim.x * 512) {
        if (idx < 32768) { const int e8 = idx & 1023, dir = (idx >> 10) & 1, head = (idx >> 11) & 7, sq = idx >> 14; scan_task<1>(ST, DEC, sq * 64, 64, head, dir, e8 * 8); }
        else { const int j = idx - 32768; const int e16 = j & 511, dir = (j >> 9) & 1, head = (j >> 10) & 7, sq = j >> 13; scan_task<2>(ST, DEC, 128 + sq * 32, 32, head, dir, e16 * 16); }
    }
}
__device__ __forceinline__ void ssd_out_unit(const Args& A, LAS unsigned char* lds, int c, int g, int tid, int lane, int wave) {
    unsigned char* ws = A.ws; const int t0 = c * 128;
    const bf16* XS = (const bf16*)((const unsigned char*)A.out + 2 * SLOT); const bf16* BC = (const bf16*)((const unsigned char*)A.out + 3 * SLOT); const bf16* Z = (const bf16*)(ws + 2 * SLOT); const bf16* ST = (const bf16*)A.out;
    bf16* MIX = (bf16*)(ws + 3 * SLOT); float* ssq = (float*)(ws + OFF_SSQ) + (size_t)T * 6;
    ssd_vectors(A, lds, t0, g, wave, lane);
    stage_rows128(BC + (size_t)t0 * 512 + g * 128, 512, lds + L_BIMG, tid);
    stage_rows128(BC + (size_t)t0 * 512 + 256 + g * 128, 512, lds + L_CIMG, tid);
    LDSW(); __syncthreads();
    const int kg = lane >> 4, l15 = lane & 15, il = 16 * wave + l15;
    bf16x8 cf[4];
#pragma unroll
    for (int ks = 0; ks < 4; ++ks) cf[ks] = *(const LAS bf16x8*)(lds + L_CIMG + il * BSTR + (32 * ks + 8 * kg) * 2);
    f32x4 cb[8];
#pragma unroll
    for (int jt = 0; jt < 8; ++jt) { cb[jt] = (f32x4){0.f, 0.f, 0.f, 0.f};
#pragma unroll
        for (int ks = 0; ks < 4; ++ks) { const bf16x8 bf_ = *(const LAS bf16x8*)(lds + L_BIMG + (16 * jt + l15) * BSTR + (32 * ks + 8 * kg) * 2); cb[jt] = MFMA16(bf_, cf[ks], cb[jt]); } }
    float ssqa[4] = {0.f, 0.f, 0.f, 0.f};
    v4u xr[2], pr[4];
    {
#pragma unroll
        for (int i = 0; i < 2; ++i) { const int idx = tid + 512 * i, row = idx >> 3, ch = idx & 7; xr[i] = *(const v4u*)(XS + (size_t)(t0 + row) * 512 + (4 * g) * 64 + ch * 8); }
        const bf16* sp = ST + (size_t)((c * 8 + 4 * g) * 2) * 8192;
#pragma unroll
        for (int i = 0; i < 4; ++i) pr[i] = *(const v4u*)(sp + (size_t)(tid + 512 * i) * 8);
    }
    for (int hh = 0; hh < 4; ++hh) {
        const int head = 4 * g + hh;
        bf16 zr[4][4];
        __syncthreads();
#pragma unroll
        for (int e = 0; e < 4; ++e)
#pragma unroll
            for (int pt = 0; pt < 4; ++pt) zr[e][pt] = Z[(size_t)(t0 + 16 * wave + 4 * kg + e) * 512 + head * 64 + 16 * pt + l15];
#pragma unroll
        for (int i = 0; i < 2; ++i) { const int idx = tid + 512 * i, row = idx >> 3, ch = idx & 7; *(LAS v4u*)(lds + L_XIMG + row * XSTR + ch * 16) = xr[i]; }
#pragma unroll
        for (int i = 0; i < 4; ++i) { const int idx = tid + 512 * i, row = idx >> 4, ch = idx & 15; *(LAS v4u*)(lds + L_PIMG + row * BSTR + ch * 16) = pr[i]; }
        if (hh < 3) {
#pragma unroll
            for (int i = 0; i < 2; ++i) { const int idx = tid + 512 * i, row = idx >> 3, ch = idx & 7; xr[i] = *(const v4u*)(XS + (size_t)(t0 + row) * 512 + (head + 1) * 64 + ch * 8); }
            const bf16* sp = ST + (size_t)((c * 8 + head + 1) * 2) * 8192;
#pragma unroll
            for (int i = 0; i < 4; ++i) pr[i] = *(const v4u*)(sp + (size_t)(tid + 512 * i) * 8);
        }
        LDSW(); __syncthreads();
        const LAS float* vdtf = (LAS float*)(lds + L_VDT) + hh * 256; const LAS float* vdtb = vdtf + 128;
        const LAS float* vcf = (LAS float*)(lds + L_VCUM) + hh * 256; const LAS float* vcb = vcf + 128;
        const float acf_i = vcf[il], ecb_i = vcb[il], Dh = A.in[10][head], totb = ((LAS float*)(lds + L_VTOT))[hh * 2 + 1];
        f32x4 Y[4];
#pragma unroll
        for (int pt = 0; pt < 4; ++pt) Y[pt] = (f32x4){0.f, 0.f, 0.f, 0.f};
#pragma unroll
        for (int ks = 0; ks < 4; ++ks) {
            f32x4 wv[2];
#pragma unroll
            for (int h2 = 0; h2 < 2; ++h2) { const int jt = 2 * ks + h2, j0 = 16 * jt + 4 * kg;
                const f32x4 cfj = *(const LAS f32x4*)(vcf + j0), dfj = *(const LAS f32x4*)(vdtf + j0), cbj = *(const LAS f32x4*)(vcb + j0), dbj = *(const LAS f32x4*)(vdtb + j0);
                if (jt < wave) {
#pragma unroll
                    for (int e = 0; e < 4; ++e) wv[h2][e] = cb[jt][e] * (__expf(fminf(acf_i - cfj[e], 0.f)) * dfj[e]);
                } else if (jt > wave) {
#pragma unroll
                    for (int e = 0; e < 4; ++e) wv[h2][e] = cb[jt][e] * (__expf(fminf(cbj[e] - ecb_i, 0.f)) * dbj[e]);
                } else {
#pragma unroll
                    for (int e = 0; e < 4; ++e) { const int j = j0 + e;
                        const float mf = j <= il ? __expf(fminf(acf_i - cfj[e], 0.f)) * dfj[e] : 0.f, mb = j >= il ? __expf(fminf(cbj[e] - ecb_i, 0.f)) * dbj[e] : 0.f;
                        wv[h2][e] = cb[jt][e] * (mf + mb) + (j == il ? Dh : 0.f); } } }
            const bf16x8 wf = pack8(wv[0], wv[1]);
#pragma unroll
            for (int pt = 0; pt < 4; ++pt) { const bf16x8 xf = tr_frag(lds + L_XIMG, XSTR, 32 * ks + 4 * kg, 32 * ks + 16 + 4 * kg, 16 * pt, lane); Y[pt] = MFMA16(wf, xf, Y[pt]); }
        }
#pragma unroll
        for (int dir = 0; dir < 2; ++dir) {
            f32x4 a2[4];
#pragma unroll
            for (int pt = 0; pt < 4; ++pt) a2[pt] = (f32x4){0.f, 0.f, 0.f, 0.f};
#pragma unroll
            for (int ks = 0; ks < 4; ++ks)
#pragma unroll
                for (int pt = 0; pt < 4; ++pt) { const bf16x8 pf = *(const LAS bf16x8*)(lds + L_PIMG + (dir * 64 + 16 * pt + l15) * BSTR + (32 * ks + 8 * kg) * 2); a2[pt] = MFMA16(cf[ks], pf, a2[pt]); }
            const f32x4 cv = *(const LAS f32x4*)((dir ? vcb : vcf) + 16 * wave + 4 * kg);
#pragma unroll
            for (int e = 0; e < 4; ++e) { const float sc = dir ? __expf(fminf(totb - cv[e], 0.f)) : __expf(fminf(cv[e], 0.f));
#pragma unroll
                for (int pt = 0; pt < 4; ++pt) Y[pt][e] += sc * a2[pt][e]; }
        }
#pragma unroll
        for (int e = 0; e < 4; ++e) { const size_t tok = (size_t)(t0 + 16 * wave + 4 * kg + e);
#pragma unroll
            for (int pt = 0; pt < 4; ++pt) { const int col = head * 64 + 16 * pt + l15; const float z = bf1(zr[e][pt]); const float y = Y[pt][e] * z * __builtin_amdgcn_rcpf(1.0f + __expf(-z));
                ssqa[e] += y * y; MIX[tok * 1024 + col] = (bf16)f2bf(y); } }
    }
#pragma unroll
    for (int e = 0; e < 4; ++e) { float s = ssqa[e]; s += __shfl_xor(s, 1); s += __shfl_xor(s, 2); s += __shfl_xor(s, 4); s += __shfl_xor(s, 8);
        if (l15 == 0) unsafeAtomicAdd(ssq + t0 + 16 * wave + 4 * kg + e, s); }
    __syncthreads();
}
constexpr int L_ACC = 0, ACCSTR = 272, L_DEN = 256 * ACCSTR  , L_VST = L_DEN + 1024  , VSTR = 144, VST_BYTES = 32 * VSTR;
struct DG { int dsh, r, m0, Lc, mtl; };
__device__ __forceinline__ DG dgeom(int task, int wave, int tb, int ss, int L) {
    DG g; const int pi = task < 2 ? task : 2; g.dsh = 2 * pi; const int qt = 2 * wave + (task == 3 ? 1 : 0); const int tsh = 4 - g.dsh;
    g.r = qt >> tsh; const int mt = qt & ((1 << tsh) - 1); g.mtl = 16 * mt; g.m0 = ((tb - ss) >> g.dsh) + g.mtl; g.Lc = L >> g.dsh; return g; }
__device__ __forceinline__ void dkload(const bf16* K, int head, int ss, const DG& g, int c, int lane, bf16x8 (&kk)[4]) {
    const int kg = lane >> 4, l15 = lane & 15;
#pragma unroll
    for (int t = 0; t < 2; ++t) { int mk = g.m0 - 64 + 32 * c + 16 * t + l15; mk = mk < 0 ? 0 : (mk > g.Lc - 1 ? g.Lc - 1 : mk); const unsigned ko = (unsigned)(((ss + (mk << g.dsh) + g.r) * 512 + head * 64 + 8 * kg) * 2);
        kk[2 * t] = *(const bf16x8*)((const char*)K + ko); kk[2 * t + 1] = *(const bf16x8*)((const char*)K + ko + 64); }
}
template <bool TWO, bool HASNEXT> __device__ __forceinline__ void dtask(const bf16* Q, const bf16* K, const bf16* V, int head, int ss, const DG& g, const DG& gn, bf16x8 (&kk)[5][4], bf16x8 (&kn)[5][4],
                                                                        LAS unsigned char* lds, LAS unsigned char* vst, float c1, float c2, int lane) {
    constexpr int NQ = TWO ? 2 : 1; const int kg = lane >> 4, l15 = lane & 15;
    bf16x8 qf[NQ][2];
#pragma unroll
    for (int j = 0; j < NQ; ++j) { const int tokq = ss + ((g.m0 + 16 * j + l15) << g.dsh) + g.r;
#pragma unroll
        for (int ks = 0; ks < 2; ++ks) qf[j][ks] = *(const bf16x8*)((const char*)Q + (unsigned)((tokq * 512 + head * 64 + 32 * ks + 8 * kg) * 2)); }
    float den[NQ]; f32x4 O[NQ][4];
#pragma unroll
    for (int j = 0; j < NQ; ++j) { den[j] = 0.f;
#pragma unroll
        for (int dt = 0; dt < 4; ++dt) O[j][dt] = (f32x4){0.f, 0.f, 0.f, 0.f}; }
#pragma unroll
    for (int grp = 0; grp < 3; ++grp) {
        const int cb = grp * 2, ce = grp == 2 ? 5 : cb + 2;
        bf16x8 kq[2][4]; bf16x8 pf[2][NQ]; v4u vv[2][4];
#pragma unroll
        for (int c = cb; c < ce; ++c) dkload(K, head, ss, g, c, lane, kq[c - cb]);
#pragma unroll
        for (int c = cb; c < ce; ++c) {
            const int kb = g.m0 - 64 + 32 * c;
#pragma unroll
            for (int j = 0; j < NQ; ++j) { f32x4 st[2]; const int mq = g.m0 + 16 * j + l15; const int klo = mq - 64 > 0 ? mq - 64 : 0, khi = mq + 64 < g.Lc - 1 ? mq + 64 : g.Lc - 1; const unsigned kspan = (unsigned)(khi - klo);
#pragma unroll
                for (int t = 0; t < 2; ++t) { st[t] = MFMA16(kq[c - cb][2 * t], qf[j][0], ((f32x4){0.f, 0.f, 0.f, 0.f})); st[t] = MFMA16(kq[c - cb][2 * t + 1], qf[j][1], st[t]); }
#pragma unroll
                for (int t = 0; t < 2; ++t)
#pragma unroll
                    for (int e = 0; e < 4; ++e) { const int mk = kb + 16 * t + 4 * kg + e; const bool ok = (unsigned)(mk - klo) <= kspan;
                        const float p = ok ? __builtin_amdgcn_exp2f(st[t][e] * c1 - c2) : 0.f; st[t][e] = p; den[j] += p; }
                pf[c - cb][j] = pack8(st[0], st[1]); }
        }
        asm volatile("" ::: "memory");
#pragma unroll
        for (int c = cb; c < ce; ++c) {
            const int kb = g.m0 - 64 + 32 * c;
#pragma unroll
            for (int i = 0; i < 4; ++i) { int mk = kb + (lane >> 3) + 8 * i; mk = mk < 0 ? 0 : (mk > g.Lc - 1 ? g.Lc - 1 : mk); vv[c - cb][i] = *(const v4u*)((const char*)V + (unsigned)(((ss + (mk << g.dsh) + g.r) * 512 + head * 64 + 8 * (lane & 7)) * 2)); }
        }
#pragma unroll
        for (int c = cb; c < ce; ++c) {
            LDSW();
#pragma unroll
            for (int i = 0; i < 4; ++i) *(LAS v4u*)(vst + ((lane >> 3) + 8 * i) * VSTR + (lane & 7) * 16) = vv[c - cb][i];
            LDSW();
#pragma unroll
            for (int dt = 0; dt < 4; ++dt) { const bf16x8 vf = tr_frag(vst, VSTR, 4 * kg, 16 + 4 * kg, 16 * dt, lane);
#pragma unroll
                for (int j = 0; j < NQ; ++j) O[j][dt] = MFMA16(vf, pf[c - cb][j], O[j][dt]); }
        }
    }
#pragma unroll
    for (int j = 0; j < NQ; ++j) { float d = den[j]; d += __shfl_xor(d, 16); d += __shfl_xor(d, 32);
        const int tl = ((g.mtl + 16 * j + l15) << g.dsh) + g.r;
#pragma unroll
        for (int dt = 0; dt < 4; ++dt) { LAS f32x4* ap = (LAS f32x4*)(lds + L_ACC + tl * ACCSTR + (16 * dt + 4 * kg) * 4); *ap = *ap + O[j][dt]; }
        if (kg == 0) { LAS float* dp = (LAS float*)(lds + L_DEN) + tl; *dp = *dp + d; } }
}
#define DBAR() do { LDSW(); __builtin_amdgcn_s_barrier(); asm volatile("" ::: "memory"); } while (0)
constexpr int GSTR = 144;
template <int HPC> __device__ __forceinline__ void dstage(const bf16* X, int head, int ss, int Lc, int dsh, int ra, int mbase, LAS unsigned char* img, int row0, int tid) {
    v4u v[6];
#pragma unroll
    for (int i = 0; i < 6; ++i) { const int idx = tid + 512 * i, row = idx >> 3, ch = idx & 7; const int cls = row / HPC; int mk = mbase + (row - cls * HPC); mk = mk < 0 ? 0 : (mk > Lc - 1 ? Lc - 1 : mk);
        v[i] = *(const v4u*)((const char*)X + (unsigned)(((ss + (mk << dsh) + ra + cls) * 512 + head * 64 + ch * 8) * 2)); }
#pragma unroll
    for (int i = 0; i < 6; ++i) { const int idx = tid + 512 * i, row = idx >> 3, ch = idx & 7; *(LAS v4u*)(img + (row0 + row) * GSTR + ch * 16) = v[i]; }
}
template <int NQ> __device__ __forceinline__ void dfused(const bf16* Q, int head, int ss, const DG& g, int krow0, LAS unsigned char* img, float c1, float c2, int lane, f32x4 (&O)[NQ][4], float (&den)[NQ]) {
    const int kg = lane >> 4, l15 = lane & 15;
    bf16x8 qf[NQ][2]; unsigned klo[NQ], kspan[NQ];
#pragma unroll
    for (int j = 0; j < NQ; ++j) { const int mq = g.m0 + 16 * j + l15; const int tokq = ss + (mq << g.dsh) + g.r;
#pragma unroll
        for (int ks = 0; ks < 2; ++ks) qf[j][ks] = *(const bf16x8*)((const char*)Q + (unsigned)((tokq * 512 + head * 64 + 32 * ks + 8 * kg) * 2));
        const int lo = mq - 64 > 0 ? mq - 64 : 0, hi = mq + 64 < g.Lc - 1 ? mq + 64 : g.Lc - 1; klo[j] = (unsigned)lo; kspan[j] = (unsigned)(hi - lo); den[j] = 0.f;
#pragma unroll
        for (int dt = 0; dt < 4; ++dt) O[j][dt] = (f32x4){0.f, 0.f, 0.f, 0.f}; }
#pragma unroll 1
    for (int c = 0; c < 5; ++c) {
        const int kb = g.m0 - 64 + 32 * c; const int row = krow0 + 32 * c;
        const int t1 = (NQ == 1 && c == 4) ? 0 : 16;
        bf16x8 kf[2][2];
#pragma unroll
        for (int t = 0; t < 2; ++t) { const LAS unsigned char* kp = img + (row + t1 * t + l15) * GSTR + kg * 16; kf[t][0] = *(const LAS bf16x8*)kp; kf[t][1] = *(const LAS bf16x8*)(kp + 64); }
        bf16x8 pf[NQ];
#pragma unroll
        for (int j = 0; j < NQ; ++j) { f32x4 st[2];
#pragma unroll
            for (int t = 0; t < 2; ++t) { st[t] = MFMA16(kf[t][0], qf[j][0], ((f32x4){0.f, 0.f, 0.f, 0.f})); st[t] = MFMA16(kf[t][1], qf[j][1], st[t]); }
#pragma unroll
            for (int t = 0; t < 2; ++t)
#pragma unroll
                for (int e = 0; e < 4; ++e) { const int mk = kb + 16 * t + 4 * kg + e; const bool ok = ((unsigned)mk - klo[j]) <= kspan[j];
                    const float p = ok ? __builtin_amdgcn_exp2f(st[t][e] * c1 - c2) : 0.f; st[t][e] = p; den[j] += p; }
            pf[j] = pack8(st[0], st[1]); }
#pragma unroll
        for (int dt = 0; dt < 4; ++dt) { const bf16x8 vf = tr_frag(img, GSTR, 384 + row + 4 * kg, 384 + row + t1 + 4 * kg, 16 * dt, lane);
#pragma unroll
            for (int j = 0; j < NQ; ++j) O[j][dt] = MFMA16(vf, pf[j], O[j][dt]); }
    }
#pragma unroll
    for (int j = 0; j < NQ; ++j) { float d = den[j]; d += __shfl_xor(d, 16); d += __shfl_xor(d, 32); den[j] = d; }
}
__device__ __forceinline__ void dattn_unit(const Args& A, LAS unsigned char* lds, int blk, int head, int tid, int lane, int wave, int flags) {
    unsigned char* ws = A.ws; const int tb = blk * 256; int ss, L; seq_of(tb, ss, L);
    const bf16* Q = (const bf16*)(ws + 5 * SLOT); const bf16* K = (const bf16*)(ws + 6 * SLOT); const bf16* V = (const bf16*)(ws + 7 * SLOT);
    bf16* MIX = (bf16*)(ws + 3 * SLOT); float* ssq = (float*)(ws + OFF_SSQ) + (size_t)T * 7;
    LAS unsigned char* vst = lds + L_VST + wave * VST_BYTES;
    const int kg = lane >> 4, l15 = lane & 15, pos0 = tb - ss;
    const DG g2 = dgeom(2, wave, tb, ss, L), g3 = dgeom(3, wave, tb, ss, L);
    bf16x8 ka[5][4];
    const float mq_ = wave_max(fabsf(A.in[12][lane])), mk_ = wave_max(fabsf(A.in[13][lane]));
    const float c1 = 0.125f * LOG2E, c2 = 8.0f * mq_ * mk_ * LOG2E;
    f32x4 O1[2][4], O2a[1][4], O2b[1][4]; float den1[2], den2a[1], den2b[1];
    DG gp1; gp1.dsh = 0; gp1.r = 0; gp1.mtl = 32 * wave; gp1.m0 = pos0 + 32 * wave; gp1.Lc = L;
    dstage<384>(K, head, ss, L, 0, 0, pos0 - 64, lds, 0, tid); asm volatile("" ::: "memory");
    dstage<384>(V, head, ss, L, 0, 0, pos0 - 64, lds, 384, tid);
    DBAR();
    dfused<2>(Q, head, ss, gp1, 32 * wave, lds, c1, c2, lane, O1, den1);
    DBAR();
    DG gp2; gp2.dsh = 2; gp2.mtl = 16 * (wave & 3); gp2.m0 = (pos0 >> 2) + gp2.mtl; gp2.Lc = L >> 2;
    gp2.r = wave >> 2;
    dstage<192>(K, head, ss, L >> 2, 2, 0, (pos0 >> 2) - 64, lds, 0, tid); asm volatile("" ::: "memory");
    dstage<192>(V, head, ss, L >> 2, 2, 0, (pos0 >> 2) - 64, lds, 384, tid);
    DBAR();
    dfused<1>(Q, head, ss, gp2, 192 * (wave >> 2) + 16 * (wave & 3), lds, c1, c2, lane, O2a, den2a);
    DBAR();
    dstage<192>(K, head, ss, L >> 2, 2, 2, (pos0 >> 2) - 64, lds, 0, tid); asm volatile("" ::: "memory");
    dstage<192>(V, head, ss, L >> 2, 2, 2, (pos0 >> 2) - 64, lds, 384, tid);
    DBAR();
    gp2.r = 2 + (wave >> 2);
    dfused<1>(Q, head, ss, gp2, 192 * (wave >> 2) + 16 * (wave & 3), lds, c1, c2, lane, O2b, den2b);
    DBAR();
#pragma unroll
    for (int j = 0; j < 2; ++j) { const int tl = 32 * wave + 16 * j + l15;
#pragma unroll
        for (int dt = 0; dt < 4; ++dt) *(LAS f32x4*)(lds + L_ACC + tl * ACCSTR + (16 * dt + 4 * kg) * 4) = O1[j][dt];
        if (kg == 0) ((LAS float*)(lds + L_DEN))[tl] = den1[j]; }
    DBAR();
    { const int tl = ((16 * (wave & 3) + l15) << 2) + (wave >> 2);
#pragma unroll
      for (int dt = 0; dt < 4; ++dt) { LAS f32x4* ap = (LAS f32x4*)(lds + L_ACC + tl * ACCSTR + (16 * dt + 4 * kg) * 4); *ap = *ap + O2a[0][dt]; }
      if (kg == 0) { LAS float* dp = (LAS float*)(lds + L_DEN) + tl; *dp = *dp + den2a[0]; }
      const int tl2 = tl + 2;
#pragma unroll
      for (int dt = 0; dt < 4; ++dt) { LAS f32x4* ap = (LAS f32x4*)(lds + L_ACC + tl2 * ACCSTR + (16 * dt + 4 * kg) * 4); *ap = *ap + O2b[0][dt]; }
      if (kg == 0) { LAS float* dp = (LAS float*)(lds + L_DEN) + tl2; *dp = *dp + den2b[0]; } }
    DBAR();
    if (!(flags & 2)) { dtask<false, false>(Q, K, V, head, ss, g2, g3, ka, ka, lds, vst, c1, c2, lane);
    dtask<false, false>(Q, K, V, head, ss, g3, g3, ka, ka, lds, vst, c1, c2, lane); }
    DBAR();
    { const int tl = tid >> 1, d0 = (tid & 1) * 32; const float inv = 1.0f / ((LAS float*)(lds + L_DEN))[tl]; float s = 0.f; float o[32];
#pragma unroll
      for (int i = 0; i < 8; ++i) { const f32x4 a = *(LAS f32x4*)(lds + L_ACC + tl * ACCSTR + (d0 + 4 * i) * 4); o[4 * i] = a[0] * inv; o[4 * i + 1] = a[1] * inv; o[4 * i + 2] = a[2] * inv; o[4 * i + 3] = a[3] * inv; }
#pragma unroll
      for (int i = 0; i < 32; ++i) s += o[i] * o[i];
      s += __shfl_xor(s, 1); if ((tid & 1) == 0) unsafeAtomicAdd(ssq + tb + tl, s);
      bf16* op = MIX + (size_t)(tb + tl) * 1024 + 512 + head * 64 + d0;
#pragma unroll
      for (int i = 0; i < 4; ++i) { v4u w; w.x = pk2(o[8 * i], o[8 * i + 1]); w.y = pk2(o[8 * i + 2], o[8 * i + 3]); w.z = pk2(o[8 * i + 4], o[8 * i + 5]); w.w = pk2(o[8 * i + 6], o[8 * i + 7]); *(v4u*)(op + 8 * i) = w; } }
    DBAR();
}
__device__ __forceinline__ void phase_mixnorm(const Args& A, int tid) {
    bf16* MIX = (bf16*)(A.ws + 3 * SLOT); const float* sa = (const float*)(A.ws + OFF_SSQ) + (size_t)T * 6; const float* sb = sa + T;
    const int c8 = tid & 127, NB = gridDim.x;
    for (int r4 = blockIdx.x; r4 < T / 4; r4 += 4 * NB) {
        v4u q[4]; float rs[4];
#pragma unroll
        for (int i = 0; i < 4; ++i) { int rr = r4 + i * NB; rr = rr < T / 4 ? rr : T / 4 - 1; const int row = rr * 4 + (tid >> 7);
            q[i] = *(const v4u*)(MIX + (size_t)row * 1024 + c8 * 8); rs[i] = (c8 < 64 ? sa[row] : sb[row]); }
#pragma unroll
        for (int i = 0; i < 4; ++i) { int rr = r4 + i * NB; if (rr >= T / 4) continue; const int row = rr * 4 + (tid >> 7);
            const float s = 1.0f / sqrtf(rs[i] * (1.0f / 512.0f) + EPS); float x[8];
            x[0] = bflo(q[i].x) * s; x[1] = bfhi(q[i].x) * s; x[2] = bflo(q[i].y) * s; x[3] = bfhi(q[i].y) * s; x[4] = bflo(q[i].z) * s; x[5] = bfhi(q[i].z) * s; x[6] = bflo(q[i].w) * s; x[7] = bfhi(q[i].w) * s;
            store8(MIX + (size_t)row * 1024 + c8 * 8, x); }
    }
}
__device__ __forceinline__ void xattn_unit(const Args& A, LAS unsigned char* lds, int blk, int head, int tid, int lane, int wave) {
    constexpr int XS2 = 528;
    unsigned char* ws = A.ws; const int tb = blk * 128; const int sq = tb < TP ? (tb >> 13) : 2 + ((tb - TP) >> 12);
    const bf16* QX = (const bf16*)(ws + 5 * SLOT); const bf16* KX = (const bf16*)(ws + OFF_KX) + (size_t)sq * 256 * 1024 + head * 256;
    const bf16* VXT = (const bf16*)(ws + OFF_VXT) + (size_t)head * 256 * NMEM + sq * 256; bf16* XO = (bf16*)(ws + 3 * SLOT);
    const float* ssqq = (const float*)(ws + OFF_SSQ) + (size_t)T * 2;
#pragma unroll 4
    for (int i = 0; i < 16; ++i) { const int idx = tid + 512 * i, row = idx >> 5, ch = idx & 31; *(LAS v4u*)(lds + row * XS2 + ch * 16) = *(const v4u*)(KX + (size_t)row * 1024 + ch * 8); }
    float gm = 0.f;
#pragma unroll
    for (int i = 0; i < 4; ++i) gm = fmaxf(gm, fabsf(A.in[20][lane + 64 * i] * A.in[21][lane + 64 * i]));
    gm = wave_max(gm); const float c2 = 16.0f * gm * LOG2E;
    const int kg = lane >> 4, l15 = lane & 15;
    const int tok = tb + 16 * wave + l15;
    const float c1 = (1.0f / sqrtf(ssqq[(size_t)tok * 4 + head] * (1.0f / 256.0f) + EPS)) * (0.0625f * LOG2E);
    bf16x8 qf[8];
#pragma unroll
    for (int ks = 0; ks < 8; ++ks) qf[ks] = *(const bf16x8*)(QX + (size_t)tok * 1024 + head * 256 + 32 * ks + 8 * kg);
    LDSW(); __syncthreads();
    v4u pw[8]; float den = 0.f;
#pragma unroll
    for (int mt = 0; mt < 16; ++mt) {
        f32x4 st = (f32x4){0.f, 0.f, 0.f, 0.f};
#pragma unroll
        for (int ks = 0; ks < 8; ++ks) { const bf16x8 a = *(const LAS bf16x8*)(lds + (16 * mt + l15) * XS2 + (32 * ks + 8 * kg) * 2); st = MFMA16(a, qf[ks], st); }
        float p[4];
#pragma unroll
        for (int e = 0; e < 4; ++e) { p[e] = __builtin_amdgcn_exp2f(st[e] * c1 - c2); den += p[e]; }
        asm volatile("" ::: "memory");
        if (mt & 1) { pw[mt >> 1].z = pk2(p[0], p[1]); pw[mt >> 1].w = pk2(p[2], p[3]); } else { pw[mt >> 1].x = pk2(p[0], p[1]); pw[mt >> 1].y = pk2(p[2], p[3]); }
    }
    __syncthreads();
#pragma unroll 4
    for (int i = 0; i < 16; ++i) { const int idx = tid + 512 * i, row = idx >> 5, ch = idx & 31; *(LAS v4u*)(lds + row * XS2 + ch * 16) = *(const v4u*)(VXT + (size_t)row * NMEM + ch * 8); }
    den += __shfl_xor(den, 16); den += __shfl_xor(den, 32); const float inv = 1.0f / den;
    LDSW(); __syncthreads();
#pragma unroll 2
    for (int dt = 0; dt < 16; ++dt) {
        f32x4 O = (f32x4){0.f, 0.f, 0.f, 0.f};
#pragma unroll
        for (int c = 0; c < 8; ++c) { const LAS unsigned char* vp = lds + (16 * dt + l15) * XS2 + (32 * c + 4 * kg) * 2; const v2u a = *(const LAS v2u*)vp, b = *(const LAS v2u*)(vp + 32);
            const bf16x8 af = __builtin_bit_cast(bf16x8, ((v4u){a.x, a.y, b.x, b.y})); O = MFMA16(af, __builtin_bit_cast(bf16x8, pw[c]), O); }
        v2u w; w.x = pk2(O[0] * inv, O[1] * inv); w.y = pk2(O[2] * inv, O[3] * inv);
        *(v2u*)(XO + (size_t)tok * 1024 + head * 256 + 16 * dt + 4 * kg) = w;
    }
    __syncthreads();
}
#ifndef MK_ONE_LAUNCH
#define MK_ONE_LAUNCH 1
#endif
constexpr int NPHASE = 13;
__global__ void __launch_bounds__(512, 2) hymba_fwd(Args args) {
    extern __shared__ __attribute__((aligned(16))) unsigned char lds_raw[];
    LAS unsigned char* lds = (LAS unsigned char*)lds_raw;
    const int tid = threadIdx.x, lane = tid & 63, wave = __builtin_amdgcn_readfirstlane(tid >> 6);
    unsigned char* ws = args.ws; const int G = gridDim.x;
    const int lo = args.ph_lo, hi = args.ph_hi;
#define IN(k) (lo <= (k) && (k) < hi)
#define SEAM(k) do { if (IN(k) && IN((k) + 1)) xcd_barrier(bar); } while (0)
    using namespace pg8;
    if (tid < 16) ((LAS unsigned*)(lds + LDS_BYTES - 64))[tid] = 0u;
    __syncthreads();
    XcdBarrier bar = xcd_barrier_post((unsigned*)(ws + OFF_BAR), (volatile LAS unsigned*)(lds + LDS_BYTES - 64));
    float* ssq = (float*)(ws + OFF_SSQ);
    int vcu = (int)blockIdx.x, cxcd = (int)blockIdx.x;
    if (args.pad == 0x5a5a5a5a) cg::this_grid().sync();
    if (IN(0)) { phase_prologue(args, lds, tid, lane, wave); } SEAM(0);
    if (lo == 0 && hi > 1) {
        volatile LAS unsigned* stw = (volatile LAS unsigned*)(lds + LDS_BYTES - 64);
        if (tid == 0) { bool even = (G % 8) == 0; const unsigned per = (unsigned)(G / 8);
            for (unsigned j = 0; j < 16; ++j) { const unsigned cnt = xb_ld(&bar.bar[XB_XCNT(j)]); if (cnt != (j < 8 ? per : 0u)) even = false; }
            const unsigned rank = stw[4];
            if (even && bar.x < 8u && rank < per) { stw[5] = bar.x * per + rank; stw[6] = rank * 8u + bar.x; } else { stw[5] = blockIdx.x; stw[6] = blockIdx.x; } }
        __syncthreads();
        vcu = (int)stw[5]; cxcd = (int)stw[6];
    }
    if (IN(1)) {
        { Gemm g{(const bf16_t*)ws, (const bf16_t*)(ws + OFF_WIN), T, 3328, 1024}; StaticOrder S; S.init(T, 3328, G, cxcd);
          EpiG<1> E{(bf16_t*)(ws + 2 * SLOT), 512, nullptr, nullptr, nullptr, nullptr, nullptr, SLOT / 2, (float*)(ws + OFF_DT), nullptr};
          gemm_phase<EpiG<1>, StaticOrder, true, true>(lds, g, S, E); }
    } SEAM(1);
    if (IN(2)) { phase_elementwise(args, tid, lane); } SEAM(2);
    if (IN(3)) {
        for (int u = blockIdx.x; u < 768; u += G) ssd_states_unit(args, lds, u >> 1, u & 1, tid, lane, wave);
        if (!(args.flags & 1)) for (int v = vcu; v < 1536; v += G) dattn_unit(args, lds, v % 192, v / 192, tid, lane, wave, args.flags);
    } SEAM(3);
    if (IN(4)) {
        phase_scan(args, tid);
        { Gemm g{(const bf16_t*)(ws + OFF_MEMN), (const bf16_t*)(ws + OFF_WKV), NMEM, 1024, 1024}; StaticOrder S; S.init(NMEM, 1024, G, ((int)blockIdx.x + G - (192 % G)) % G);
          EpiG<0> E{(bf16_t*)(ws + OFF_KX), 1024, nullptr, nullptr, nullptr, nullptr, nullptr, 0, nullptr, nullptr};
          gemm_phase<EpiG<0>, StaticOrder, true, true>(lds, g, S, E); }
        { Gemm g{(const bf16_t*)(ws + OFF_WKV) + (size_t)1024 * 1024, (const bf16_t*)(ws + OFF_MEMN), 1024, NMEM, 1024}; StaticOrder S; S.init(1024, NMEM, G, ((int)blockIdx.x + G - (232 % G)) % G);
          EpiG<0> E{(bf16_t*)(ws + OFF_VXT), NMEM, nullptr, nullptr, nullptr, nullptr, nullptr, 0, nullptr, nullptr};
          gemm_phase<EpiG<0>, StaticOrder, true, true>(lds, g, S, E); }
    } SEAM(4);
    if (IN(5)) { for (int u = blockIdx.x; u < 768; u += G) ssd_out_unit(args, lds, u >> 1, u & 1, tid, lane, wave); } SEAM(5);
    if (IN(6)) { phase_mixnorm(args, tid); phase_kxnorm(args, tid); } SEAM(6);
    if (IN(7)) {
        Gemm g{(const bf16_t*)(ws + 3 * SLOT), (const bf16_t*)(ws + OFF_WOUT), T, 1024, 1024}; StaticOrder S; S.init(T, 1024, G, cxcd);
        EpiG<2> E{(bf16_t*)ws, 1024, nullptr, nullptr, nullptr, ssq, (const float*)(ws + OFF_IRS), 0, nullptr, (const bf16_t*)ws};
        gemm_phase<EpiG<2>, StaticOrder, true, true>(lds, g, S, E);
    } SEAM(7);
    if (IN(8)) {
        Gemm g{(const bf16_t*)ws, (const bf16_t*)(ws + OFF_WQ), T, 1024, 1024}; StaticOrder S; S.init(T, 1024, G, cxcd);
        EpiG<3> E{(bf16_t*)(ws + 5 * SLOT), 1024, nullptr, nullptr, nullptr, ssq + (size_t)T * 2, ssq, 0, nullptr};
        gemm_phase<EpiG<3>, StaticOrder, true, true>(lds, g, S, E);
    } SEAM(8);
    if (IN(9)) { for (int v = vcu; v < 1536; v += G) xattn_unit(args, lds, v % 384, v / 384, tid, lane, wave); } SEAM(9);
    if (IN(10)) {
        Gemm g{(const bf16_t*)(ws + 3 * SLOT), (const bf16_t*)(ws + OFF_WO), T, 1024, 1024}; StaticOrder S; S.init(T, 1024, G, cxcd);
        EpiG<5> E{(bf16_t*)(ws + OFF_HB2), 1024, nullptr, nullptr, nullptr, ssq + T, nullptr, 0, nullptr, (const bf16_t*)ws};
        gemm_phase<EpiG<5>, StaticOrder, true, true>(lds, g, S, E);
    } SEAM(10);
    if (IN(11)) {
        Gemm g{(const bf16_t*)(ws + OFF_HB2), (const bf16_t*)(ws + OFF_W1), T, 4096, 1024}; StaticOrder S; S.init(T, 4096, G, cxcd);
        EpiG<6> E{(bf16_t*)ws, 4096, nullptr, nullptr, nullptr, nullptr, ssq + T, 0, nullptr};
        gemm_phase<EpiG<6>, StaticOrder, true, true>(lds, g, S, E);
    } SEAM(11);
    if (IN(12)) {
        Gemm g{(const bf16_t*)ws, (const bf16_t*)(ws + OFF_W2), T, 1024, 4096}; StaticOrder S; S.init(T, 1024, G, cxcd);
        EpiG<7> E{nullptr, 0, args.out, nullptr, nullptr, nullptr, nullptr, 0, nullptr, (const bf16_t*)(ws + OFF_HB2)};
        gemm_phase<EpiG<7>, StaticOrder, true, true>(lds, g, S, E);
    }
#undef IN
#undef SEAM
}

extern "C" void kernel_launch(void* const* d_in, const int* in_sizes, int n_in, void* d_out, int out_size, void* d_ws, size_t ws_size, hipStream_t stream) {
    static int grid = 0;
    if (grid == 0) {
        if (n_in != 26 || out_size != T * 1024 || ws_size < WS_NEED) { fprintf(stderr, "kernel_launch: unexpected shapes (n_in %d out %d ws %zu)\n", n_in, out_size, ws_size); grid = -1; return; }
        int dev = 0, cus = 0, per_cu = 0;
        (void)hipGetDevice(&dev); (void)hipDeviceGetAttribute(&cus, hipDeviceAttributeMultiprocessorCount, dev);
        if (hipFuncSetAttribute((const void*)hymba_fwd, hipFuncAttributeMaxDynamicSharedMemorySize, LDS_BYTES) != hipSuccess) { fprintf(stderr, "kernel_launch: hipFuncSetAttribute failed\n"); grid = -1; return; }
        (void)hipOccupancyMaxActiveBlocksPerMultiprocessor(&per_cu, (const void*)hymba_fwd, 512, LDS_BYTES);
        if (per_cu < 1) per_cu = 1;
        grid = cus * per_cu; (void)hipGetLastError();
    }
    if (grid < 0) return;
    (void)hipMemsetAsync((char*)d_ws + OFF_BAR, 0, 16384, stream);
    Args a{};
    for (int i = 0; i < 26; ++i) a.in[i] = (const float*)d_in[i];
    a.out = (float*)d_out; a.ws = (unsigned char*)d_ws;
#if MK_ONE_LAUNCH
    void* kargs[] = {&a};
#ifdef PROBE_K
    a.ph_lo = 0; a.ph_hi = PROBE_K + 1; a.flags = PROBE_FLAGS;
    (void)hipLaunchCooperativeKernel((const void*)hymba_fwd, dim3(grid), dim3(512), kargs, LDS_BYTES, stream);
    (void)hipMemsetAsync((char*)d_ws + OFF_BAR, 0, 16384, stream);
#endif
    a.ph_lo = 0; a.ph_hi = NPHASE; a.flags = 0;
    hipError_t e = hipLaunchCooperativeKernel((const void*)hymba_fwd, dim3(grid), dim3(512), kargs, LDS_BYTES, stream);
    if (e != hipSuccess) fprintf(stderr, "cooperative launch failed: %s (grid %d)\n", hipGetErrorString(e), grid);
#else
    for (int p = 0; p < NPHASE; ++p) { a.ph_lo = p; a.ph_hi = p + 1; hipLaunchKernelGGL(hymba_fwd, dim3(grid), dim3(512), LDS_BYTES, stream, a); }
#endif
}
```
